# Optimizing an MI355X kernel written in HIP

```python
import math
import jax
import jax.numpy as jnp
from jax import lax
import numpy as np

D_MODEL = 2048
BATCH = 1
SEQ = 8192
DEPTH = 4

N_A_LAYERS = DEPTH // 2
N_B_LAYERS = DEPTH - N_A_LAYERS
PLE_DIM = 256
FFN_DIM = -(-8 * D_MODEL // (3 * 256)) * 256

GMLP_CHUNK = 128
GMLP_WIDTH = D_MODEL
GMLP_GROUP_DIM = 128
GMLP_GROUPS = GMLP_WIDTH // GMLP_GROUP_DIM

HEAD_DIM = 128
N_HEADS = D_MODEL // HEAD_DIM
N_KV_GROUPS = 2
HEADS_PER_GROUP = N_HEADS // N_KV_GROUPS
N_BRANCH = 3
CMP_BLOCK = 32
CMP_STRIDE = 16
CMP_HIDDEN = 256
SLC_BLOCK = 64
N_SELECT = 16
WINDOW = 512
Q_BLOCK = 128
N_BUCKETS = 32
MAX_DISTANCE = 128
EPS = 1e-6
NEG_INF = -1e30

kernel_name = 'hybrid_gmlp_nsa_yoco_trunk'


def rmsnorm(x, g):
    xf = x.astype(jnp.float32)
    y = xf * lax.rsqrt(jnp.mean(xf * xf, axis=-1, keepdims=True) + EPS)
    return (y * g.astype(jnp.float32)).astype(x.dtype)


def t5_bucket(dist):
    n = jnp.maximum(dist, 0)
    max_exact = N_BUCKETS // 2
    nf = jnp.maximum(n, 1).astype(jnp.float32)
    large = max_exact + (jnp.log(nf / max_exact) / math.log(MAX_DISTANCE / max_exact)
                         * (N_BUCKETS - max_exact)).astype(jnp.int32)
    large = jnp.minimum(large, N_BUCKETS - 1)
    return jnp.where(n < max_exact, n, large)


def rel_bias_heads(table, dist):
    b = table[t5_bucket(dist)]
    b = jnp.transpose(b, (2, 0, 1)).reshape(N_KV_GROUPS, HEADS_PER_GROUP, *dist.shape)
    return b.astype(jnp.float32)


def swiglu(h, w_in, w_out):
    g, u = jnp.split(h @ w_in, 2, axis=-1)
    return (jax.nn.silu(g) * u) @ w_out


def ple_add(x, p_i, norm_g, w_proj, w_gate):
    gate = jax.nn.sigmoid(rmsnorm(x, norm_g) @ w_gate)
    return x + (p_i @ w_proj) * gate


def gmlp_mixer(h, w_in, norm_v, w_s, b_s, w_out):
    B, S, _ = h.shape
    z = jax.nn.gelu(h @ w_in)
    u, v = jnp.split(z, 2, axis=-1)
    v = rmsnorm(v, norm_v)
    v = v.reshape(B, S // GMLP_CHUNK, GMLP_CHUNK, GMLP_GROUPS, GMLP_GROUP_DIM)
    causal = jnp.tril(jnp.ones((GMLP_CHUNK, GMLP_CHUNK), dtype=bool))
    ws = jnp.where(causal, w_s, 0)
    sv = jnp.einsum('gts,bcsgd->bctgd', ws, v) + jnp.transpose(b_s)[None, None, :, :, None]
    return (u * sv.reshape(B, S, GMLP_WIDTH)) @ w_out


def compress_blocks(t, pe, w1, w2):
    B, G, S, Dk = t.shape
    halves = t.reshape(B, G, S // CMP_STRIDE, CMP_STRIDE, Dk)
    blocks = jnp.concatenate([halves[:, :, :-1], halves[:, :, 1:]], axis=3) + pe
    flat = blocks.reshape(B, G, blocks.shape[2], CMP_BLOCK * Dk)
    return jax.nn.gelu(flat @ w1) @ w2


def shared_kv(x, kv_norm, kv_w, k_norm, cmp_pe_k, cmp_pe_v, cmp_wk1, cmp_wk2, cmp_wv1, cmp_wv2):
    B, S, _ = x.shape
    h = rmsnorm(x, kv_norm)
    kv = (h @ kv_w).reshape(B, S, 2 * N_BRANCH, N_KV_GROUPS, HEAD_DIM)
    kv = jnp.transpose(kv, (2, 0, 3, 1, 4))
    k_c, v_c, k_s, v_s, k_w, v_w = kv[0], kv[1], kv[2], kv[3], kv[4], kv[5]
    k_cmp = rmsnorm(compress_blocks(k_c, cmp_pe_k, cmp_wk1, cmp_wk2), k_norm[0])
    v_cmp = compress_blocks(v_c, cmp_pe_v, cmp_wv1, cmp_wv2)
    k_s = rmsnorm(k_s, k_norm[1])
    k_w = rmsnorm(k_w, k_norm[2])
    k_slc_b = k_s.reshape(B, N_KV_GROUPS, S // SLC_BLOCK, SLC_BLOCK, HEAD_DIM)
    v_slc_b = v_s.reshape(B, N_KV_GROUPS, S // SLC_BLOCK, SLC_BLOCK, HEAD_DIM)
    pad = ((0, 0), (0, 0), (WINDOW, 0), (0, 0))
    return (k_cmp, v_cmp, k_slc_b, v_slc_b, jnp.pad(k_w, pad), jnp.pad(v_w, pad))


def nsa_mixer(h, k_cmp, v_cmp, k_slc_b, v_slc_b, k_win_pad, v_win_pad, w_in, q_norm, rel_table, w_out):
    B, S, _ = h.shape
    n_qb = S // Q_BLOCK
    n_cmp = k_cmp.shape[2]
    n_slc = k_slc_b.shape[2]
    n_sel = min(N_SELECT, n_slc)
    scale = HEAD_DIM ** -0.5

    proj = h @ w_in
    q = rmsnorm(proj[..., :N_HEADS * HEAD_DIM].reshape(B, S, N_HEADS, HEAD_DIM), q_norm)
    gates = jax.nn.sigmoid(proj[..., N_HEADS * HEAD_DIM:].astype(jnp.float32))
    q_blocks = q.reshape(B, n_qb, Q_BLOCK, N_KV_GROUPS, HEADS_PER_GROUP, HEAD_DIM).transpose(1, 0, 3, 4, 2, 5)
    g_blocks = gates.reshape(B, n_qb, Q_BLOCK, N_KV_GROUPS, HEADS_PER_GROUP, N_BRANCH).transpose(1, 0, 3, 4, 2, 5)
    starts = jnp.arange(n_qb, dtype=jnp.int32) * Q_BLOCK

    cmp_end = jnp.arange(n_cmp, dtype=jnp.int32) * CMP_STRIDE + CMP_BLOCK - 1
    c0 = jnp.arange(n_cmp, dtype=jnp.int32) * CMP_STRIDE
    s0 = jnp.arange(n_slc, dtype=jnp.int32) * SLC_BLOCK
    lo = jnp.maximum(c0[:, None], s0[None, :])
    hi = jnp.minimum(c0[:, None] + CMP_BLOCK, s0[None, :] + SLC_BLOCK)
    overlap = jnp.maximum(hi - lo, 0).astype(jnp.float32) / CMP_BLOCK
    blk = jnp.arange(n_slc, dtype=jnp.int32)
    bi = jnp.arange(B)[:, None, None, None]
    gi = jnp.arange(N_KV_GROUPS)[None, :, None, None]
    gi5 = jnp.arange(N_KV_GROUPS)[None, :, None, None, None]
    hi5 = jnp.arange(HEADS_PER_GROUP)[None, None, :, None, None]
    tab = jnp.transpose(rel_table.reshape(N_BUCKETS, N_KV_GROUPS, HEADS_PER_GROUP), (1, 2, 0))

    def block_fn(args):
        qb, gb, s = args
        t = s + jnp.arange(Q_BLOCK, dtype=jnp.int32)
        lc = jnp.einsum('bghqd,bgkd->bghqk', qb, k_cmp, preferred_element_type=jnp.float32) * scale \
            + rel_bias_heads(rel_table, t[:, None] - cmp_end[None, :])
        mc = cmp_end[None, :] <= t[:, None]
        pc = jax.nn.softmax(jnp.where(mc, lc, NEG_INF), axis=-1) * jnp.any(mc, axis=-1)[:, None]
        o_cmp = jnp.einsum('bghqk,bgkd->bghqd', pc.astype(v_cmp.dtype), v_cmp)
        imp = jnp.einsum('bghqk,kj->bgqj', pc, overlap)
        cur = t // SLC_BLOCK
        forced = (blk[None, :] == 0) | (blk[None, :] == cur[:, None]) | (blk[None, :] == cur[:, None] - 1)
        valid = blk[None, :] <= cur[:, None]
        score = jnp.where(forced, jnp.inf, jnp.where(valid, imp, -jnp.inf))
        _, sel = lax.top_k(score, n_sel)
        k_sel = k_slc_b[bi, gi, sel].reshape(B, N_KV_GROUPS, Q_BLOCK, n_sel * SLC_BLOCK, HEAD_DIM)
        v_sel = v_slc_b[bi, gi, sel].reshape(B, N_KV_GROUPS, Q_BLOCK, n_sel * SLC_BLOCK, HEAD_DIM)
        pos = (sel[..., None] * SLC_BLOCK + jnp.arange(SLC_BLOCK, dtype=jnp.int32)).reshape(B, N_KV_GROUPS, Q_BLOCK, -1)
        dist = t[None, None, :, None] - pos
        bias_s = tab[gi5, hi5, t5_bucket(dist)[:, :, None]].astype(jnp.float32)
        ls = jnp.einsum('bghqd,bgqkd->bghqk', qb, k_sel, preferred_element_type=jnp.float32) * scale + bias_s
        ps = jax.nn.softmax(jnp.where(dist[:, :, None] >= 0, ls, NEG_INF), axis=-1)
        o_slc = jnp.einsum('bghqk,bgqkd->bghqd', ps.astype(v_sel.dtype), v_sel)
        kw = lax.dynamic_slice_in_dim(k_win_pad, s, WINDOW + Q_BLOCK, axis=2)
        vw = lax.dynamic_slice_in_dim(v_win_pad, s, WINDOW + Q_BLOCK, axis=2)
        posw = s - WINDOW + jnp.arange(WINDOW + Q_BLOCK, dtype=jnp.int32)
        dw = t[:, None] - posw[None, :]
        mw = (dw >= 0) & (dw < WINDOW) & (posw[None, :] >= 0)
        lw = jnp.einsum('bghqd,bgkd->bghqk', qb, kw, preferred_element_type=jnp.float32) * scale \
            + rel_bias_heads(rel_table, dw)
        pw = jax.nn.softmax(jnp.where(mw, lw, NEG_INF), axis=-1)
        o_win = jnp.einsum('bghqk,bgkd->bghqd', pw.astype(vw.dtype), vw)
        out = gb[..., 0:1] * o_cmp + gb[..., 1:2] * o_slc + gb[..., 2:3] * o_win
        return out.astype(qb.dtype)

    o = lax.map(block_fn, (q_blocks, g_blocks, starts))
    o = o.transpose(1, 0, 4, 2, 3, 5).reshape(B, S, N_HEADS * HEAD_DIM)
    return o @ w_out


def _normal(key, shape, scale):
    return scale * jax.random.normal(key, shape, jnp.float32)


def _gain(key, shape):
    return 1.0 + 0.02 * jax.random.normal(key, shape, jnp.float32)


def setup_inputs(seed: int = 0) -> dict:
    key = jax.random.key(seed)
    ks = jax.random.split(key, 27)
    q_cols = N_HEADS * HEAD_DIM + N_HEADS * N_BRANCH
    kv_cols = 2 * N_BRANCH * N_KV_GROUPS * HEAD_DIM
    return {
        'x': jax.random.normal(ks[0], (BATCH, SEQ, D_MODEL), jnp.float32),
        'p': jax.random.normal(ks[1], (DEPTH, BATCH, SEQ, PLE_DIM), jnp.float32),
        'norm_mix': _gain(ks[2], (DEPTH, D_MODEL)),
        'norm_ffn': _gain(ks[3], (DEPTH, D_MODEL)),
        'norm_ple': _gain(ks[4], (DEPTH, D_MODEL)),
        'a_w_in': _normal(ks[5], (N_A_LAYERS, D_MODEL, 2 * GMLP_WIDTH), D_MODEL ** -0.5),
        'a_norm_v': _gain(ks[6], (N_A_LAYERS, GMLP_WIDTH)),
        'a_w_s': _normal(ks[7], (N_A_LAYERS, GMLP_GROUPS, GMLP_CHUNK, GMLP_CHUNK), GMLP_CHUNK ** -0.5),
        'a_b_s': 1.0 + _normal(ks[8], (N_A_LAYERS, GMLP_GROUPS, GMLP_CHUNK), 0.1),
        'a_w_out': _normal(ks[9], (N_A_LAYERS, GMLP_WIDTH, D_MODEL), GMLP_WIDTH ** -0.5),
        'kv_norm': _gain(ks[10], (D_MODEL,)),
        'kv_w': _normal(ks[11], (D_MODEL, kv_cols), D_MODEL ** -0.5),
        'k_norm': _gain(ks[12], (N_BRANCH, HEAD_DIM)),
        'cmp_pe_k': _normal(ks[13], (CMP_BLOCK, HEAD_DIM), 0.1),
        'cmp_pe_v': _normal(ks[14], (CMP_BLOCK, HEAD_DIM), 0.1),
        'cmp_wk1': _normal(ks[15], (CMP_BLOCK * HEAD_DIM, CMP_HIDDEN), (CMP_BLOCK * HEAD_DIM) ** -0.5),
        'cmp_wk2': _normal(ks[16], (CMP_HIDDEN, HEAD_DIM), CMP_HIDDEN ** -0.5),
        'cmp_wv1': _normal(ks[17], (CMP_BLOCK * HEAD_DIM, CMP_HIDDEN), (CMP_BLOCK * HEAD_DIM) ** -0.5),
        'cmp_wv2': _normal(ks[18], (CMP_HIDDEN, HEAD_DIM), CMP_HIDDEN ** -0.5),
        'b_w_in': _normal(ks[19], (N_B_LAYERS, D_MODEL, q_cols), D_MODEL ** -0.5),
        'b_q_norm': _gain(ks[20], (N_B_LAYERS, HEAD_DIM)),
        'b_w_out': _normal(ks[21], (N_B_LAYERS, N_HEADS * HEAD_DIM, D_MODEL), (N_HEADS * HEAD_DIM) ** -0.5),
        'rel_bias': _normal(ks[22], (N_BUCKETS, N_HEADS), 0.5),
        'ffn_w_in': _normal(ks[23], (DEPTH, D_MODEL, 2 * FFN_DIM), D_MODEL ** -0.5),
        'ffn_w_out': _normal(ks[24], (DEPTH, FFN_DIM, D_MODEL), FFN_DIM ** -0.5),
        'ple_w': _normal(ks[25], (DEPTH, PLE_DIM, D_MODEL), PLE_DIM ** -0.5),
        'ple_gate': _normal(ks[26], (DEPTH, D_MODEL, D_MODEL), D_MODEL ** -0.5),
    }


def reference(x, p, norm_mix, norm_ffn, norm_ple, a_w_in, a_norm_v, a_w_s, a_b_s, a_w_out,
              kv_norm, kv_w, k_norm, cmp_pe_k, cmp_pe_v, cmp_wk1, cmp_wk2, cmp_wv1, cmp_wv2,
              b_w_in, b_q_norm, b_w_out, rel_bias, ffn_w_in, ffn_w_out, ple_w, ple_gate):
    kvs = None
    for i in range(DEPTH):
        h = rmsnorm(x, norm_mix[i])
        if i < N_A_LAYERS:
            x = x + gmlp_mixer(h, a_w_in[i], a_norm_v[i], a_w_s[i], a_b_s[i], a_w_out[i])
        else:
            j = i - N_A_LAYERS
            x = x + nsa_mixer(h, *kvs, b_w_in[j], b_q_norm[j], rel_bias, b_w_out[j])
        x = x + swiglu(rmsnorm(x, norm_ffn[i]), ffn_w_in[i], ffn_w_out[i])
        x = ple_add(x, p[i], norm_ple[i], ple_w[i], ple_gate[i])
        if i == N_A_LAYERS - 1:
            kvs = shared_kv(x, kv_norm, kv_w, k_norm, cmp_pe_k, cmp_pe_v, cmp_wk1, cmp_wk2, cmp_wv1, cmp_wv2)
    return x
```

```cpp
#include <hip/hip_runtime.h>
#include <hip/hip_cooperative_groups.h>
#include <cstdio>
#include <cstdint>
namespace cg = cooperative_groups;

#define LAS __attribute__((address_space(3)))
typedef unsigned short bf16_t;
typedef short bf16x8 __attribute__((ext_vector_type(8)));
typedef float f32x4 __attribute__((ext_vector_type(4)));
typedef float f32x2 __attribute__((ext_vector_type(2)));
typedef unsigned u32x4 __attribute__((ext_vector_type(4)));
typedef unsigned u32x2 __attribute__((ext_vector_type(2)));

constexpr int SEQ = 8192, DM = 2048, FFD = 5632, PLED = 256, NQP = 2304, NKVC = 1536;
constexpr float EPSF = 1e-6f;
constexpr int NTHREADS = 512;
constexpr int LDS_BYTES = 147456 + 64;

constexpr size_t O_WAIN  = 0;
constexpr size_t O_WAOUT = O_WAIN  + 2ull * 4096 * 2048 * 2;
constexpr size_t O_WFIN  = O_WAOUT + 2ull * 2048 * 2048 * 2;
constexpr size_t O_WFOUT = O_WFIN  + 4ull * 11264 * 2048 * 2;
constexpr size_t O_WPG   = O_WFOUT + 4ull * 2048 * 5632 * 2;
constexpr size_t O_WPW   = O_WPG   + 4ull * 2048 * 2048 * 2;
constexpr size_t O_WKV   = O_WPW   + 4ull * 2048 * 256 * 2;
constexpr size_t O_WBIN  = O_WKV   + 1536ull * 2048 * 2;
constexpr size_t O_WBOUT = O_WBIN  + 2ull * 2304 * 2048 * 2;
constexpr size_t O_WC1   = O_WBOUT + 2ull * 2048 * 2048 * 2;
constexpr size_t O_WC2   = O_WC1   + 2ull * 256 * 4096 * 2;
constexpr size_t O_WSB   = O_WC2   + 2ull * 256 * 256 * 2;
constexpr size_t O_XB    = O_WSB   + 2ull * 16 * 128 * 128 * 2;
constexpr size_t O_ZU    = O_XB    + 2ull * 8192 * 2048 * 2;
constexpr size_t O_ZV    = O_ZU    + 8192ull * 2048 * 2;
constexpr size_t O_Y     = O_ZV    + 8192ull * 2048 * 2;
constexpr size_t O_HID   = O_Y     + 8192ull * 2048 * 2;
constexpr size_t O_PROJ  = O_HID   + 8192ull * 5632 * 2;
constexpr size_t O_PB    = O_PROJ  + 8192ull * 2048 * 2;
constexpr size_t O_GATES = O_PB    + 4ull * 8192 * 256 * 2;
constexpr size_t O_KC    = O_GATES + 8192ull * 48 * 4;
constexpr size_t O_VC    = O_KC    + 2ull * 8192 * 128 * 2 + 16384;
constexpr size_t O_KVTMP = O_VC    + 2ull * 8192 * 128 * 2 + 16384;
constexpr size_t O_KS    = O_KVTMP + 8ull * 8192 * 128 * 4;
constexpr size_t O_VS    = O_KS    + 2ull * 8192 * 128 * 2;
constexpr size_t O_KW    = O_VS    + 2ull * 8192 * 128 * 2;
constexpr size_t O_VW    = O_KW    + 2ull * 8192 * 128 * 2;
constexpr size_t O_HK    = O_VW    + 2ull * 8192 * 128 * 2;
constexpr size_t O_HV    = O_HK    + 1024ull * 256 * 2;
constexpr size_t O_CRAW  = O_HV    + 1024ull * 256 * 2;
constexpr size_t O_KCMP  = O_CRAW  + 2ull * 1024 * 128 * 4;
constexpr size_t O_VCMP  = O_KCMP  + 2ull * 512 * 128 * 2;
constexpr size_t O_SS    = O_VCMP  + 2ull * 512 * 128 * 2;
constexpr size_t O_SSV   = O_SS    + 13ull * 8192 * 32 * 4;
constexpr size_t O_CB    = O_SSV   + 2ull * 8192 * 32 * 4;
constexpr size_t O_BAR   = O_CB    + 2048;
constexpr size_t BAR_BYTES = 16384;
constexpr size_t O_END   = O_BAR   + BAR_BYTES;

__device__ __forceinline__ unsigned cvt_pk_bf16(float lo, float hi) { unsigned r; asm volatile("v_cvt_pk_bf16_f32 %0, %1, %2" : "=v"(r) : "v"(lo), "v"(hi)); return r; }
__device__ __forceinline__ float bf2f(unsigned short b) { return __uint_as_float(((unsigned)b) << 16); }
__device__ __forceinline__ float bflo(unsigned w) { return __uint_as_float(w << 16); }
__device__ __forceinline__ float bfhi(unsigned w) { return __uint_as_float(w & 0xffff0000u); }
typedef _Float16 f16x8 __attribute__((ext_vector_type(8)));
typedef _Float16 f16x2 __attribute__((ext_vector_type(2)));
__device__ __forceinline__ unsigned cvt_pk_f16(float lo, float hi) { const f16x2 v = {(_Float16)lo, (_Float16)hi}; return __builtin_bit_cast(unsigned, v); }
__device__ __forceinline__ float h2lo(unsigned w) { const f16x2 v = __builtin_bit_cast(f16x2, w); return (float)v[0]; }
__device__ __forceinline__ float h2hi(unsigned w) { const f16x2 v = __builtin_bit_cast(f16x2, w); return (float)v[1]; }
__device__ __forceinline__ float fexp(float x) { return __builtin_amdgcn_exp2f(x * 1.4426950408889634f); }
__device__ __forceinline__ float sigm(float x) { return __builtin_amdgcn_rcpf(1.0f + fexp(-x)); }
__device__ __forceinline__ float gelu_t(float x) { const float z = 1.5957691216057308f * (x + 0.044715f * x * x * x); return x * sigm(z); }
__device__ __forceinline__ float wave_sum(float v) {
#pragma unroll
    for (int o = 1; o < 64; o <<= 1) v += __shfl_xor(v, o);
    return v;
}
#define LDS_WAIT() asm volatile("s_waitcnt lgkmcnt(0)" ::: "memory")
__device__ __forceinline__ int otid() { int t; asm volatile("v_mov_b32 %0, %1" : "=v"(t) : "v"((int)threadIdx.x)); return t; }

namespace pg8 {
constexpr int BM = 256, BK = 64, HALF = 128, HTB = HALF * BK * 2, STAGE_BYTES = 8 * HTB, NXCD = 8, WGM = 8;
__host__ __device__ __forceinline__ int lds_byte(int r, int c) { const int st = (r >> 4) * 2 + (c >> 5), rr = r & 15, cc = c & 31, ob = rr * 64 + cc * 2; return st * 1024 + (ob ^ (((ob >> 9) & 1) << 5)); }
__host__ __device__ __forceinline__ void stage_rc(int b, int& R, int& C) { const int st = b / 1024, sb = b % 1024, swz = sb ^ (((sb >> 9) & 1) << 5); R = (st >> 1) * 16 + swz / 64; C = (st & 1) * 32 + (swz % 64) / 2; }
struct Unit { int pm, pn; };
struct Gemm { const bf16_t* A; const bf16_t* Bt; int M, N, K, lda; };
struct StaticOrder {
    int nM, nN, nwg, G, c;
    __device__ void init(int M, int N, int G_, int c_) { nM = M / BM; nN = N / BM; nwg = nM * nN; G = G_; c = c_; }
    __device__ bool next(int i, Unit& u) const {
        const long L = (long)i * G + c; if (L >= nwg) return false;
        int wgid = (int)L; { const int q = nwg / NXCD, r = nwg % NXCD, xcd = wgid % NXCD, off = wgid / NXCD; wgid = (xcd < r ? xcd * (q + 1) : r * (q + 1) + (xcd - r) * q) + off; }
        const int nig = WGM * nN, gid = wgid / nig, fm = gid * WGM, gsz = (nM - fm) < WGM ? (nM - fm) : WGM;
        u.pm = fm + ((wgid % nig) % gsz); u.pn = (wgid % nig) / gsz; return true;
    }
};
template <class Epi>
__device__ __forceinline__ void gemm_phase(LAS unsigned char* lds, const Gemm g, const StaticOrder& S, const Epi& E) {
    const int tid = otid(), wid = __builtin_amdgcn_readfirstlane(tid >> 6), lane = tid & 63, wr = wid >> 2, wc = wid & 3, fr = lane & 15, fq = lane >> 4;
    const int K = g.K, nt = K / BK;
    unsigned voffA[2], voffB[2];
#pragma unroll
    for (int i = 0; i < 2; ++i) { int R, C; stage_rc(tid * 16 + i * 8192, R, C);
        const int rho = R & 31, Rb = (R & ~31) + 8 * ((rho & 15) >> 2) + 4 * (rho >> 4) + (rho & 3);
        voffA[i] = (unsigned)(R * g.lda + C) * 2u; voffB[i] = (unsigned)(Rb * K + C) * 2u; }
    const size_t kstep = (size_t)(BK * 2);
    const size_t hstepA = (size_t)HALF * g.lda * 2, hstepB = (size_t)HALF * K * 2;
    const size_t tstepA = 2 * hstepA, tstepB = 2 * hstepB;
    const unsigned ldsw = (unsigned)wid * 1024u;
    const int aoff = lds_byte(wr * 64 + fr, fq * 8), boff = lds_byte(wc * 32 + fr, fq * 8);
#define PG8_SA(b, h) (((b) * 2 + (h)) * HTB)
#define PG8_SB(b, h) ((4 + (b) * 2 + (h)) * HTB)
#define PG8_STAGE(bufoff, gbase, voff) do { _Pragma("unroll") for (int _i = 0; _i < 2; ++_i) \
        __builtin_amdgcn_global_load_lds((const unsigned*)((const char*)(gbase) + (voff)[_i]), (LAS unsigned*)(lds + (bufoff) + ldsw + _i * 8192), 16, 0, 0); } while (0)
#define PG8_LDA(dst, b, h) do { _Pragma("unroll") for (int m = 0; m < 4; ++m) _Pragma("unroll") for (int k = 0; k < 2; ++k) dst[m][k] = *(const LAS bf16x8*)(lds + PG8_SA(b, h) + aoff + m * 2048 + k * 1024); } while (0)
#define PG8_LDB(dst, b, h) do { _Pragma("unroll") for (int n = 0; n < 2; ++n) _Pragma("unroll") for (int k = 0; k < 2; ++k) dst[n][k] = *(const LAS bf16x8*)(lds + PG8_SB(b, h) + boff + n * 2048 + k * 1024); } while (0)
#define PG8_MMA(ai, bj, At, Bt) do { __builtin_amdgcn_s_setprio(1); _Pragma("unroll") for (int m = 0; m < 4; ++m) _Pragma("unroll") for (int n = 0; n < 2; ++n) _Pragma("unroll") for (int k = 0; k < 2; ++k) \
        acc[ai][bj][m][n] = Epi::F16 ? __builtin_amdgcn_mfma_f32_16x16x32_f16(__builtin_bit_cast(f16x8, Bt[n][k]), __builtin_bit_cast(f16x8, At[m][k]), acc[ai][bj][m][n], 0, 0, 0) \
                                     : __builtin_amdgcn_mfma_f32_16x16x32_bf16(Bt[n][k], At[m][k], acc[ai][bj][m][n], 0, 0, 0); __builtin_amdgcn_s_setprio(0); } while (0)
#define PG8_WAIT_V(n) asm volatile("s_waitcnt vmcnt(" #n ")" ::: "memory")
#define PG8_WAIT_L(n) asm volatile("s_waitcnt lgkmcnt(" #n ")" ::: "memory")
#define PG8_BAR __builtin_amdgcn_s_barrier()
#define PG8_SCHED __builtin_amdgcn_sched_barrier(0)
    Unit cur, nxt; int ui = 0;
    if (!S.next(0, cur)) return;
    f32x4 acc[2][2][4][2];
#pragma unroll
    for (int a = 0; a < 2; ++a)
#pragma unroll
        for (int b = 0; b < 2; ++b)
#pragma unroll
            for (int m = 0; m < 4; ++m)
#pragma unroll
                for (int n = 0; n < 2; ++n) acc[a][b][m][n] = (f32x4){0.f, 0.f, 0.f, 0.f};
    bf16x8 At[4][2], B0[2][2], B1[2][2];
    const char* cA = (const char*)g.A + (size_t)cur.pm * tstepA; const char* cB = (const char*)g.Bt + (size_t)cur.pn * tstepB;
    if (Epi::SP2) {
        PG8_STAGE(PG8_SB(0, 0), cB, voffB); PG8_STAGE(PG8_SB(0, 1), cB + hstepB, voffB); PG8_STAGE(PG8_SA(0, 0), cA, voffA); PG8_STAGE(PG8_SA(0, 1), cA + hstepA, voffA);
        if (wr == 1) PG8_BAR;
        PG8_WAIT_V(2); PG8_BAR;
    } else {
        PG8_STAGE(PG8_SB(0, 0), cB, voffB); PG8_STAGE(PG8_SA(0, 0), cA, voffA); PG8_STAGE(PG8_SB(0, 1), cB + hstepB, voffB); PG8_STAGE(PG8_SA(0, 1), cA + hstepA, voffA);
        if (wr == 1) PG8_BAR;
        PG8_WAIT_V(4); PG8_BAR;
    }
    PG8_STAGE(PG8_SB(1, 0), cB + kstep, voffB); PG8_STAGE(PG8_SA(1, 0), cA + kstep, voffA); PG8_STAGE(PG8_SB(1, 1), cB + hstepB + kstep, voffB);
    PG8_WAIT_V(6); PG8_BAR;
    for (;;) {
        const bool has_next = S.next(ui + 1, nxt);
        const char* nA = has_next ? (const char*)g.A + (size_t)nxt.pm * tstepA : cA; const char* nB = has_next ? (const char*)g.Bt + (size_t)nxt.pn * tstepB : cB;
        for (int t = 0; t < nt; t += 2) {
            const bool last = (t == nt - 2);
            const char* a1 = cA + (size_t)(t + 1) * kstep;
            const char* a2 = last ? nA : cA + (size_t)(t + 2) * kstep; const char* b2 = last ? nB : cB + (size_t)(t + 2) * kstep;
            const char* a3 = a2 + kstep; const char* b3 = b2 + kstep;
            if (Epi::SP2) {
            PG8_LDB(B0, 0, 0); PG8_LDB(B1, 0, 1); PG8_SCHED; PG8_LDA(At, 0, 0); PG8_STAGE(PG8_SA(1, 1), a1 + hstepA, voffA);
            PG8_WAIT_V(8); PG8_WAIT_L(0); PG8_BAR; PG8_MMA(0, 0, At, B0); PG8_MMA(0, 1, At, B1); PG8_BAR; PG8_SCHED;
            PG8_LDA(At, 0, 1); PG8_STAGE(PG8_SB(0, 0), b2, voffB); PG8_STAGE(PG8_SB(0, 1), b2 + hstepB, voffB); PG8_STAGE(PG8_SA(0, 0), a2, voffA);
            PG8_WAIT_V(8); PG8_WAIT_L(0); PG8_BAR; PG8_MMA(1, 0, At, B0); PG8_MMA(1, 1, At, B1); PG8_BAR; PG8_SCHED;
            PG8_LDB(B0, 1, 0); PG8_LDB(B1, 1, 1); PG8_SCHED; PG8_LDA(At, 1, 0); PG8_STAGE(PG8_SA(0, 1), a2 + hstepA, voffA);
            PG8_WAIT_V(8); PG8_WAIT_L(0); PG8_BAR; PG8_MMA(0, 0, At, B0); PG8_MMA(0, 1, At, B1); PG8_BAR; PG8_SCHED;
            PG8_LDA(At, 1, 1); PG8_STAGE(PG8_SB(1, 0), b3, voffB); PG8_STAGE(PG8_SB(1, 1), b3 + hstepB, voffB); PG8_STAGE(PG8_SA(1, 0), a3, voffA);
            PG8_WAIT_V(8); PG8_WAIT_L(0); PG8_BAR; PG8_MMA(1, 0, At, B0); PG8_MMA(1, 1, At, B1); PG8_BAR; PG8_SCHED;
            } else {
            PG8_LDB(B0, 0, 0); PG8_SCHED; PG8_LDA(At, 0, 0); PG8_STAGE(PG8_SA(1, 1), a1 + hstepA, voffA);
            PG8_WAIT_L(8); PG8_BAR; PG8_WAIT_L(0); PG8_MMA(0, 0, At, B0); PG8_BAR; PG8_SCHED;
            PG8_LDB(B1, 0, 1); PG8_STAGE(PG8_SB(0, 0), b2, voffB);
            PG8_BAR; PG8_WAIT_L(0); PG8_MMA(0, 1, At, B1); PG8_BAR;
            PG8_LDA(At, 0, 1); PG8_STAGE(PG8_SA(0, 0), a2, voffA);
            PG8_BAR; PG8_WAIT_L(0); PG8_MMA(1, 0, At, B0); PG8_BAR; PG8_SCHED;
            PG8_STAGE(PG8_SB(0, 1), b2 + hstepB, voffB);
            PG8_WAIT_V(6); PG8_BAR; PG8_MMA(1, 1, At, B1); PG8_BAR;
            PG8_LDB(B0, 1, 0); PG8_SCHED; PG8_LDA(At, 1, 0); PG8_STAGE(PG8_SA(0, 1), a2 + hstepA, voffA);
            PG8_WAIT_L(8); PG8_BAR; PG8_WAIT_L(0); PG8_MMA(0, 0, At, B0); PG8_BAR; PG8_SCHED;
            PG8_LDB(B1, 1, 1); PG8_STAGE(PG8_SB(1, 0), b3, voffB);
            PG8_BAR; PG8_WAIT_L(0); PG8_MMA(0, 1, At, B1); PG8_BAR;
            PG8_LDA(At, 1, 1); PG8_STAGE(PG8_SA(1, 0), a3, voffA);
            PG8_BAR; PG8_WAIT_L(0); PG8_MMA(1, 0, At, B0); PG8_BAR; PG8_SCHED;
            PG8_STAGE(PG8_SB(1, 1), b3 + hstepB, voffB);
            PG8_WAIT_V(6); PG8_BAR; PG8_MMA(1, 1, At, B1); PG8_BAR;
            }
        }
        if (Epi::ALIGN) { if (wr == 0) PG8_BAR; }
        E(acc, cur, wr, wc, fr, fq);
        if (!has_next) break;
#pragma unroll
        for (int a = 0; a < 2; ++a)
#pragma unroll
            for (int b = 0; b < 2; ++b)
#pragma unroll
                for (int m = 0; m < 4; ++m)
#pragma unroll
                    for (int n = 0; n < 2; ++n) acc[a][b][m][n] = (f32x4){0.f, 0.f, 0.f, 0.f};
        cur = nxt; cA = nA; cB = nB; ++ui;
        if (Epi::ALIGN) { if (wr == 1) PG8_BAR; }
    }
    PG8_WAIT_V(0);
    if (!Epi::ALIGN) { if (wr == 0) PG8_BAR; }
    PG8_BAR;
#undef PG8_SA
#undef PG8_SB
#undef PG8_STAGE
#undef PG8_LDA
#undef PG8_LDB
#undef PG8_MMA
#undef PG8_WAIT_V
#undef PG8_WAIT_L
#undef PG8_BAR
#undef PG8_SCHED
}
}

__device__ __forceinline__ float row_rstd(const float* part, int row, int fq) {
    const f32x4 a = *(const f32x4*)(part + (size_t)row * 32 + fq * 8), b = *(const f32x4*)(part + (size_t)row * 32 + fq * 8 + 4);
    float s = ((a[0] + a[1]) + (a[2] + a[3])) + ((b[0] + b[1]) + (b[2] + b[3]));
    s += __shfl_xor(s, 16); s += __shfl_xor(s, 32);
    return __builtin_amdgcn_rsqf(s * (1.0f / 2048.0f) + EPSF);
}
enum { EP_GMLP_IN = 0, EP_RESID, EP_FFN_IN, EP_PLE, EP_PROJ, EP_KV, EP_QG, EP_C1, EP_C2 };
struct EpiP {
    const float* ss_in; float* ss_out; const float* xres; float* xout; bf16_t* xb;
    bf16_t* o0; bf16_t* o1; float* f0; const bf16_t* aux; const float* bias; float* ssv;
};
__device__ __forceinline__ void st_bf16x4(bf16_t* p, f32x4 v) { u32x2 w; w.x = cvt_pk_bf16(v[0], v[1]); w.y = cvt_pk_bf16(v[2], v[3]); *(u32x2*)p = w; }
__device__ __forceinline__ void st_bf16x8(bf16_t* p, f32x4 a, f32x4 b) { u32x4 w; w.x = cvt_pk_bf16(a[0], a[1]); w.y = cvt_pk_bf16(a[2], a[3]); w.z = cvt_pk_bf16(b[0], b[1]); w.w = cvt_pk_bf16(b[2], b[3]); *(u32x4*)p = w; }
__device__ __forceinline__ void ld_bf16x8(const bf16_t* p, f32x4& a, f32x4& b) { const u32x4 w = *(const u32x4*)p;
    a[0] = bflo(w.x); a[1] = bfhi(w.x); a[2] = bflo(w.y); a[3] = bfhi(w.y); b[0] = bflo(w.z); b[1] = bfhi(w.z); b[2] = bflo(w.w); b[3] = bfhi(w.w); }

template <int MODE> struct Epi {
    EpiP p;
    static constexpr bool ALIGN = (MODE == EP_FFN_IN || MODE == EP_GMLP_IN);
    static constexpr bool SP2 = (MODE == EP_FFN_IN || MODE == EP_RESID || MODE == EP_GMLP_IN || MODE == EP_PLE || MODE == EP_QG || MODE == EP_KV);
    static constexpr bool F16 = (MODE == EP_GMLP_IN || MODE == EP_FFN_IN || MODE == EP_PLE || MODE == EP_KV || MODE == EP_QG);
    __device__ __forceinline__ void operator()(const f32x4 (&acc)[2][2][4][2], const pg8::Unit& u, int wr, int wc, int fr, int fq) const {
        const int row0 = u.pm * 256 + wr * 64 + fr;
        const int cin = wc * 32 + 8 * fq;
        constexpr bool NEEDR = F16;
        float rr[2][4];
        if (NEEDR) {
#pragma unroll
            for (int ai = 0; ai < 2; ++ai) {
                f32x4 pa[4], pb[4];
#pragma unroll
                for (int m = 0; m < 4; ++m) { const float* pp = p.ss_in + (size_t)(row0 + ai * 128 + m * 16) * 32 + fq * 8; pa[m] = *(const f32x4*)pp; pb[m] = *(const f32x4*)(pp + 4); }
                __builtin_amdgcn_sched_barrier(0);
#pragma unroll
                for (int m = 0; m < 4; ++m) { const f32x4 a = pa[m], b = pb[m]; float sm = ((a[0] + a[1]) + (a[2] + a[3])) + ((b[0] + b[1]) + (b[2] + b[3]));
                    sm += __shfl_xor(sm, 16); sm += __shfl_xor(sm, 32); rr[ai][m] = __builtin_amdgcn_rsqf(sm * (1.0f / 2048.0f) + EPSF); }
                __builtin_amdgcn_sched_barrier(0);
            }
        }
        if (MODE == EP_RESID || MODE == EP_PLE) {
            constexpr int RB = (MODE == EP_PLE) ? 1 : 4;
#pragma unroll
            for (int rb0 = 0; rb0 < 8; rb0 += RB) {
                u32x4 xr[RB][2], pr[RB][2];
#pragma unroll
                for (int q = 0; q < RB; ++q)
#pragma unroll
                    for (int bj = 0; bj < 2; ++bj) { const int ai = (rb0 + q) >> 2, m = (rb0 + q) & 3; const size_t o = (size_t)(row0 + ai * 128 + m * 16) * 2048 + u.pn * 256 + cin + bj * 128;
                        xr[q][bj] = *(const u32x4*)(p.o1 + o); if (MODE == EP_PLE) pr[q][bj] = *(const u32x4*)(p.aux + o); }
                __builtin_amdgcn_sched_barrier(0);
#pragma unroll
                for (int q = 0; q < RB; ++q) {
                    const int ai = (rb0 + q) >> 2, m = (rb0 + q) & 3;
                    const int row = row0 + ai * 128 + m * 16; const size_t off = (size_t)row * 2048 + u.pn * 256 + cin; const float r = NEEDR ? rr[ai][m] : 1.0f;
                    float sq = 0.f;
#pragma unroll
                    for (int bj = 0; bj < 2; ++bj) { const size_t o = off + bj * 128; const u32x4 w = xr[q][bj];
                        f32x4 x0, x1, a0 = acc[ai][bj][m][0], a1 = acc[ai][bj][m][1];
                        x0[0] = h2lo(w.x); x0[1] = h2hi(w.x); x0[2] = h2lo(w.y); x0[3] = h2hi(w.y); x1[0] = h2lo(w.z); x1[1] = h2hi(w.z); x1[2] = h2lo(w.w); x1[3] = h2hi(w.w);
                        if (MODE == EP_PLE) { const u32x4 qq = pr[q][bj];
                            a0[0] = bflo(qq.x) * sigm(a0[0] * r); a0[1] = bfhi(qq.x) * sigm(a0[1] * r); a0[2] = bflo(qq.y) * sigm(a0[2] * r); a0[3] = bfhi(qq.y) * sigm(a0[3] * r);
                            a1[0] = bflo(qq.z) * sigm(a1[0] * r); a1[1] = bfhi(qq.z) * sigm(a1[1] * r); a1[2] = bflo(qq.w) * sigm(a1[2] * r); a1[3] = bfhi(qq.w) * sigm(a1[3] * r); }
                        x0 = x0 + a0; x1 = x1 + a1;
                        if (p.xout) { *(f32x4*)(p.xout + o) = x0; *(f32x4*)(p.xout + o + 4) = x1; }
                        if (p.xb) { u32x4 wv; wv.x = cvt_pk_f16(x0[0], x0[1]); wv.y = cvt_pk_f16(x0[2], x0[3]); wv.z = cvt_pk_f16(x1[0], x1[1]); wv.w = cvt_pk_f16(x1[2], x1[3]); *(u32x4*)(p.xb + o) = wv; }
                        sq += ((x0[0] * x0[0] + x0[1] * x0[1]) + (x0[2] * x0[2] + x0[3] * x0[3])) + ((x1[0] * x1[0] + x1[1] * x1[1]) + (x1[2] * x1[2] + x1[3] * x1[3])); }
                    if (p.ss_out) { sq += __shfl_xor(sq, 16); sq += __shfl_xor(sq, 32); if (fq == 0) p.ss_out[(size_t)row * 32 + u.pn * 4 + wc] = sq; }
                }
                __builtin_amdgcn_sched_barrier(0);
            }
            return;
        }
        f32x4 cb[2][2];
        if (MODE == EP_C1) {
#pragma unroll
            for (int bj = 0; bj < 2; ++bj) { cb[bj][0] = *(const f32x4*)(p.bias + bj * 128 + cin); cb[bj][1] = *(const f32x4*)(p.bias + bj * 128 + cin + 4); }
        }
#pragma unroll
        for (int ai = 0; ai < 2; ++ai)
#pragma unroll
            for (int m = 0; m < 4; ++m) {
                const int row = row0 + ai * 128 + m * 16;
                const float r = NEEDR ? rr[ai][m] : 1.0f;
                if (MODE == EP_GMLP_IN) {
                    const bool isv = u.pn >= 8; bf16_t* dst = (isv ? p.o1 : p.o0) + (size_t)row * 2048 + (u.pn & 7) * 256 + cin;
                    float sq = 0.f;
#pragma unroll
                    for (int bj = 0; bj < 2; ++bj) { f32x4 v0 = acc[ai][bj][m][0] * r, v1 = acc[ai][bj][m][1] * r;
#pragma unroll
                        for (int j = 0; j < 4; ++j) { v0[j] = gelu_t(v0[j]); v1[j] = gelu_t(v1[j]); sq += v0[j] * v0[j] + v1[j] * v1[j]; }
                        st_bf16x8(dst + bj * 128, v0, v1); }
                    if (isv) { sq += __shfl_xor(sq, 16); sq += __shfl_xor(sq, 32); if (fq == 0) p.ssv[(size_t)row * 32 + (u.pn - 8) * 4 + wc] = sq; }
                } else if (MODE == EP_FFN_IN) {
                    bf16_t* dst = p.o0 + (size_t)row * FFD + u.pn * 128 + cin;
                    f32x4 h0, h1;
#pragma unroll
                    for (int j = 0; j < 4; ++j) { const float g0 = acc[ai][0][m][0][j] * r, g1 = acc[ai][0][m][1][j] * r;
                        h0[j] = g0 * sigm(g0) * (acc[ai][1][m][0][j] * r); h1[j] = g1 * sigm(g1) * (acc[ai][1][m][1][j] * r); }
                    st_bf16x8(dst, h0, h1);
                } else if (MODE == EP_PROJ) {
                    bf16_t* dst = p.o0 + (size_t)row * 2048 + u.pn * 256 + cin;
#pragma unroll
                    for (int bj = 0; bj < 2; ++bj) st_bf16x8(dst + bj * 128, acc[ai][bj][m][0], acc[ai][bj][m][1]);
                } else if (MODE == EP_KV) {
                    const int br = u.pn;
#pragma unroll
                    for (int bj = 0; bj < 2; ++bj) { const f32x4 v0 = acc[ai][bj][m][0] * r, v1 = acc[ai][bj][m][1] * r; const size_t o = ((size_t)bj * SEQ + row) * 128 + cin;
                        if (br == 0) st_bf16x8(p.o0 + o, v0, v1);
                        else if (br == 1) st_bf16x8(p.o1 + o, v0, v1);
                        else { float* d = p.f0 + (size_t)(br - 2) * 2 * SEQ * 128 + o; *(f32x4*)d = v0; *(f32x4*)(d + 4) = v1; } }
                } else if (MODE == EP_QG) {
                    if (u.pn < 8) {
                        bf16_t* dst = p.o0 + (size_t)row * 2048 + u.pn * 256 + cin;
#pragma unroll
                        for (int bj = 0; bj < 2; ++bj) st_bf16x8(dst + bj * 128, acc[ai][bj][m][0] * r, acc[ai][bj][m][1] * r);
                    } else if (cin < 48) {
#pragma unroll
                        for (int n = 0; n < 2; ++n) { f32x4 v = acc[ai][0][m][n] * r;
#pragma unroll
                            for (int j = 0; j < 4; ++j) v[j] = sigm(v[j]);
                            *(f32x4*)(p.f0 + (size_t)row * 48 + cin + 4 * n) = v; }
                    }
                } else if (MODE == EP_C1) {
#pragma unroll
                    for (int bj = 0; bj < 2; ++bj) { const int c = bj * 128 + cin; f32x4 v0 = acc[ai][bj][m][0] + cb[bj][0], v1 = acc[ai][bj][m][1] + cb[bj][1];
#pragma unroll
                        for (int j = 0; j < 4; ++j) { v0[j] = gelu_t(v0[j]); v1[j] = gelu_t(v1[j]); }
                        st_bf16x8(p.o0 + (size_t)row * 256 + c, v0, v1); }
                } else if (MODE == EP_C2) {
                    float* d = p.f0 + (size_t)row * 128 + cin; *(f32x4*)d = acc[ai][0][m][0]; *(f32x4*)(d + 4) = acc[ai][0][m][1];
                }
            }
    }
};

struct Params {
    const float *x, *p, *norm_mix, *norm_ffn, *norm_ple, *a_w_in, *a_norm_v, *a_w_s, *a_b_s, *a_w_out, *kv_norm, *kv_w, *k_norm,
        *cmp_pe_k, *cmp_pe_v, *cmp_wk1, *cmp_wk2, *cmp_wv1, *cmp_wv2, *b_w_in, *b_q_norm, *b_w_out, *rel_bias, *ffn_w_in, *ffn_w_out, *ple_w, *ple_gate;
    float* out; unsigned char* ws;
};

__device__ __forceinline__ void transpose_item(const float* __restrict__ W, int K, int Nsrc, int Npad, bf16_t* WT, const float* gain, int mode, LAS float* scr, int item, int lane) {
    const int nblk = Npad / 64, kb = item / nblk, nb = item % nblk, k0 = 64 * kb, n0 = 64 * nb;
    const int r4 = lane >> 4, c4 = (lane & 15) * 4; const bool ok = n0 + c4 < Nsrc;
#pragma unroll 4
    for (int i = 0; i < 16; ++i) { const int kk = 4 * i + r4; f32x4 v = ok ? *(const f32x4*)(W + (size_t)(k0 + kk) * Nsrc + n0 + c4) : (f32x4){0.f, 0.f, 0.f, 0.f};
        if (gain) v = v * gain[k0 + kk];
        LAS float* d = scr + kk * 65 + c4; d[0] = v[0]; d[1] = v[1]; d[2] = v[2]; d[3] = v[3]; }
    LDS_WAIT();
    int drow0 = n0;
    if (mode & 1) { const int ty = n0 >= FFD ? 1 : 0, j0 = n0 - ty * FFD; drow0 = 256 * (j0 >> 7) + 128 * ty + (j0 & 127); }
    const int c = lane & 7;
#pragma unroll
    for (int j = 0; j < 8; ++j) { const int n = (lane >> 3) + 8 * j; const LAS float* sp = scr + (8 * c) * 65 + n;
        u32x4 o;
        if (mode & 2) {
            const unsigned b0 = cvt_pk_bf16(sp[0 * 65], sp[1 * 65]), b1 = cvt_pk_bf16(sp[2 * 65], sp[3 * 65]), b2 = cvt_pk_bf16(sp[4 * 65], sp[5 * 65]), b3 = cvt_pk_bf16(sp[6 * 65], sp[7 * 65]);
            o.x = cvt_pk_f16(bflo(b0), bfhi(b0)); o.y = cvt_pk_f16(bflo(b1), bfhi(b1)); o.z = cvt_pk_f16(bflo(b2), bfhi(b2)); o.w = cvt_pk_f16(bflo(b3), bfhi(b3)); }
        else { o.x = cvt_pk_bf16(sp[0 * 65], sp[1 * 65]); o.y = cvt_pk_bf16(sp[2 * 65], sp[3 * 65]); o.z = cvt_pk_bf16(sp[4 * 65], sp[5 * 65]); o.w = cvt_pk_bf16(sp[6 * 65], sp[7 * 65]); }
        *(u32x4*)(WT + (size_t)(drow0 + n) * K + k0 + 8 * c) = o; }
    LDS_WAIT();
}

__device__ __forceinline__ void convert_set(const Params& P, LAS unsigned char* lds, int set, int widx, int nw, int lane, int wave) {
    unsigned char* ws = P.ws;
    LAS float* scr = (LAS float*)lds + wave * (64 * 65);
    constexpr int I_AIN = (2048 / 64) * (4096 / 64), I_SQ = (2048 / 64) * (2048 / 64), I_FIN = (2048 / 64) * (11264 / 64), I_FOUT = (5632 / 64) * (2048 / 64),
                  I_PW = (256 / 64) * (2048 / 64), I_KV = (2048 / 64) * (1536 / 64), I_BIN = (2048 / 64) * (2304 / 64), I_C1 = (4096 / 64) * (256 / 64), I_C2 = (256 / 64) * (128 / 64);
    const int total = set == 0 ? I_AIN + I_SQ + 3 * I_FIN + 4 * I_PW
                    : set == 1 ? I_FOUT + I_SQ + I_AIN + I_SQ
                    : set == 2 ? I_FOUT + I_SQ + I_KV + I_BIN + I_SQ + 2 * I_C1 + 2 * I_C2
                    : set == 3 ? I_FOUT + I_SQ + I_BIN + I_SQ
                    : set == 4 ? I_FOUT + I_SQ
                    :            I_FIN;
    for (int item = widx; item < total; item += nw) {
        int r = item;
#define TJ(SET, CNT, W, K, NS, NP, WT, GAIN, MODE) if (set == (SET)) { if (r < (CNT)) { transpose_item((W), (K), (NS), (NP), (bf16_t*)(WT), (GAIN), (MODE), scr, r, lane); continue; } r -= (CNT); }
        TJ(0, I_AIN, P.a_w_in, 2048, 4096, 4096, ws + O_WAIN, P.norm_mix, 2)
        TJ(0, I_SQ, P.a_w_out, 2048, 2048, 2048, ws + O_WAOUT, nullptr, 0)
        TJ(0, I_FIN, P.ffn_w_in, 2048, 11264, 11264, ws + O_WFIN, P.norm_ffn, 3)
        TJ(0, I_FIN, P.ffn_w_in + 1 * 2048ull * 11264, 2048, 11264, 11264, ws + O_WFIN + 1 * 11264ull * 2048 * 2, P.norm_ffn + 2048, 3)
        TJ(0, I_FIN, P.ffn_w_in + 2 * 2048ull * 11264, 2048, 11264, 11264, ws + O_WFIN + 2 * 11264ull * 2048 * 2, P.norm_ffn + 4096, 3)
        TJ(5, I_FIN, P.ffn_w_in + 3 * 2048ull * 11264, 2048, 11264, 11264, ws + O_WFIN + 3 * 11264ull * 2048 * 2, P.norm_ffn + 6144, 3)
        TJ(0, I_PW, P.ple_w, 256, 2048, 2048, ws + O_WPW, nullptr, 0)
        TJ(0, I_PW, P.ple_w + 1 * 256ull * 2048, 256, 2048, 2048, ws + O_WPW + 1 * 2048ull * 256 * 2, nullptr, 0)
        TJ(0, I_PW, P.ple_w + 2 * 256ull * 2048, 256, 2048, 2048, ws + O_WPW + 2 * 2048ull * 256 * 2, nullptr, 0)
        TJ(0, I_PW, P.ple_w + 3 * 256ull * 2048, 256, 2048, 2048, ws + O_WPW + 3 * 2048ull * 256 * 2, nullptr, 0)
        TJ(1, I_FOUT, P.ffn_w_out, 5632, 2048, 2048, ws + O_WFOUT, nullptr, 0)
        TJ(1, I_SQ, P.ple_gate, 2048, 2048, 2048, ws + O_WPG, P.norm_ple, 2)
        TJ(1, I_AIN, P.a_w_in + 2048ull * 4096, 2048, 4096, 4096, ws + O_WAIN + 4096ull * 2048 * 2, P.norm_mix + 2048, 2)
        TJ(1, I_SQ, P.a_w_out + 2048ull * 2048, 2048, 2048, 2048, ws + O_WAOUT + 2048ull * 2048 * 2, nullptr, 0)
        TJ(2, I_FOUT, P.ffn_w_out + 1 * 5632ull * 2048, 5632, 2048, 2048, ws + O_WFOUT + 1 * 2048ull * 5632 * 2, nullptr, 0)
        TJ(2, I_SQ, P.ple_gate + 1 * 2048ull * 2048, 2048, 2048, 2048, ws + O_WPG + 1 * 2048ull * 2048 * 2, P.norm_ple + 2048, 2)
        TJ(2, I_KV, P.kv_w, 2048, 1536, 1536, ws + O_WKV, P.kv_norm, 2)
        TJ(2, I_BIN, P.b_w_in, 2048, 2096, 2304, ws + O_WBIN, P.norm_mix + 4096, 2)
        TJ(2, I_SQ, P.b_w_out, 2048, 2048, 2048, ws + O_WBOUT, nullptr, 0)
        TJ(2, I_C1, P.cmp_wk1, 4096, 256, 256, ws + O_WC1, nullptr, 0)
        TJ(2, I_C1, P.cmp_wv1, 4096, 256, 256, ws + O_WC1 + 256ull * 4096 * 2, nullptr, 0)
        TJ(2, I_C2, P.cmp_wk2, 256, 128, 128, ws + O_WC2, nullptr, 0)
        TJ(2, I_C2, P.cmp_wv2, 256, 128, 128, ws + O_WC2 + 256ull * 256 * 2, nullptr, 0)
        TJ(3, I_FOUT, P.ffn_w_out + 2 * 5632ull * 2048, 5632, 2048, 2048, ws + O_WFOUT + 2 * 2048ull * 5632 * 2, nullptr, 0)
        TJ(3, I_SQ, P.ple_gate + 2 * 2048ull * 2048, 2048, 2048, 2048, ws + O_WPG + 2 * 2048ull * 2048 * 2, P.norm_ple + 4096, 2)
        TJ(3, I_BIN, P.b_w_in + 2048ull * 2096, 2048, 2096, 2304, ws + O_WBIN + 2304ull * 2048 * 2, P.norm_mix + 6144, 2)
        TJ(3, I_SQ, P.b_w_out + 2048ull * 2048, 2048, 2048, 2048, ws + O_WBOUT + 2048ull * 2048 * 2, nullptr, 0)
        TJ(4, I_FOUT, P.ffn_w_out + 3 * 5632ull * 2048, 5632, 2048, 2048, ws + O_WFOUT + 3 * 2048ull * 5632 * 2, nullptr, 0)
        TJ(4, I_SQ, P.ple_gate + 3 * 2048ull * 2048, 2048, 2048, 2048, ws + O_WPG + 3 * 2048ull * 2048 * 2, P.norm_ple + 6144, 2)
#undef TJ
    }
}

__device__ __forceinline__ void phase_prologue(const Params& P, LAS unsigned char* lds) {
    unsigned char* ws = P.ws;
    const int tid = otid(), lane = tid & 63, wave = tid >> 6;
    const int gwave = blockIdx.x * 8 + wave, nwaves = gridDim.x * 8;
    const int gtid = blockIdx.x * NTHREADS + tid, nthr = gridDim.x * NTHREADS;
    convert_set(P, lds, 0, gwave, nwaves, lane, wave);
    if (gridDim.x != 256) { for (int st = 1; st <= 5; ++st) convert_set(P, lds, st, gwave, nwaves, lane, wave); }
    {
        bf16_t* xb = (bf16_t*)(ws + O_XB); float* ss = (float*)(ws + O_SS);
        for (int row = gwave; row < SEQ; row += nwaves) {
            const f32x4* xr = (const f32x4*)(P.x + (size_t)row * DM) + lane; float s = 0.f;
#pragma unroll
            for (int j = 0; j < 8; ++j) { const f32x4 v = xr[64 * j]; s += (v[0] * v[0] + v[1] * v[1]) + (v[2] * v[2] + v[3] * v[3]);
                u32x2 wv; wv.x = cvt_pk_f16(v[0], v[1]); wv.y = cvt_pk_f16(v[2], v[3]); *(u32x2*)(xb + (size_t)row * DM + (64 * j + lane) * 4) = wv; }
            s = wave_sum(s); if (lane < 32) ss[(size_t)row * 32 + lane] = lane == 0 ? s : 0.f;
        }
    }
    { const f32x4* src = (const f32x4*)P.p; bf16_t* dst = (bf16_t*)(ws + O_PB); for (int i = gtid; i < 4 * SEQ * PLED / 4; i += nthr) st_bf16x4(dst + (size_t)i * 4, src[i]); }
    { const f32x4* src = (const f32x4*)P.a_w_s; bf16_t* dst = (bf16_t*)(ws + O_WSB);
      for (int i = gtid; i < 2 * 16 * 128 * 128 / 4; i += nthr) { f32x4 v = src[i]; const int s0 = (i * 4) & 127, t = ((i * 4) >> 7) & 127;
#pragma unroll
          for (int j = 0; j < 4; ++j) if (s0 + j > t) v[j] = 0.f;
          st_bf16x4(dst + (size_t)i * 4, v); } }
    __syncthreads();
    if (blockIdx.x < 16) {
        const int mtx = blockIdx.x >> 3, n = (blockIdx.x & 7) * 32 + (tid & 31), ks = tid >> 5;
        const float* pe = mtx ? P.cmp_pe_v : P.cmp_pe_k; const float* w1 = mtx ? P.cmp_wv1 : P.cmp_wk1;
        float s = 0.f;
        for (int i = 0; i < 256; ++i) { const int k = ks + 16 * i; s += pe[k] * w1[(size_t)k * 256 + n]; }
        LAS float* red = (LAS float*)lds;
        red[ks * 32 + (tid & 31)] = s; LDS_WAIT(); __syncthreads();
        if (tid < 32) { float t = 0.f; for (int i = 0; i < 16; ++i) t += red[i * 32 + tid]; ((float*)(ws + O_CB))[mtx * 256 + (blockIdx.x & 7) * 32 + tid] = t; }
        __syncthreads();
    }
}

__device__ __forceinline__ void phase_sgu(const Params& P, LAS unsigned char* lds, int layer) {
    unsigned char* ws = P.ws;
    const int tid = otid(), lane = tid & 63, wave = __builtin_amdgcn_readfirstlane(tid >> 6), fr = lane & 15, fq = lane >> 4;
    const bf16_t* ZU = (const bf16_t*)(ws + O_ZU); const bf16_t* ZV = (const bf16_t*)(ws + O_ZV); bf16_t* Y = (bf16_t*)(ws + O_Y);
    const float* ssv = (const float*)(ws + O_SSV) + (size_t)layer * SEQ * 32; const float* nv = P.a_norm_v + layer * 2048; const float* bs = P.a_b_s + layer * 16 * 128;
    constexpr int LDR = 136;
    LAS bf16_t* As = (LAS bf16_t*)lds; LAS bf16_t* Bs = As + 128 * LDR; LAS float* rsl = (LAS float*)(Bs + 128 * LDR);
    for (int unit = blockIdx.x; unit < 1024; unit += gridDim.x) {
        const int g = unit & 15, c = unit >> 4;
        const bf16_t* Wsg = (const bf16_t*)(ws + O_WSB) + ((size_t)(layer * 16 + g)) * 128 * 128;
        __syncthreads();
        if (tid < 128) {
            const int row = c * 128 + tid; float ssum = 0.f;
#pragma unroll
            for (int e = 0; e < 8; ++e) { const f32x4 pv = *(const f32x4*)(ssv + (size_t)row * 32 + 4 * e); ssum += (pv[0] + pv[1]) + (pv[2] + pv[3]); }
            rsl[tid] = __builtin_amdgcn_rsqf(ssum * (1.0f / 2048.0f) + EPSF);
        }
        LDS_WAIT(); __syncthreads();
#pragma unroll
        for (int ps = 0; ps < 4; ++ps) { const int idx = tid + 512 * ps, r = idx >> 4, c16 = idx & 15;
            *(LAS u32x4*)(As + r * LDR + c16 * 8) = *(const u32x4*)(Wsg + r * 128 + c16 * 8);
            const int row = c * 128 + r; const u32x4 vv = *(const u32x4*)(ZV + (size_t)row * 2048 + g * 128 + c16 * 8);
            const float rs = rsl[r];
            const f32x4 n0 = *(const f32x4*)(nv + g * 128 + c16 * 8), n1 = *(const f32x4*)(nv + g * 128 + c16 * 8 + 4);
            const unsigned w4[4] = {vv.x, vv.y, vv.z, vv.w};
#pragma unroll
            for (int q = 0; q < 4; ++q) { const float a = bflo(w4[q]) * rs * (q < 2 ? n0[2 * q] : n1[2 * q - 4]), b = bfhi(w4[q]) * rs * (q < 2 ? n0[2 * q + 1] : n1[2 * q - 3]);
                const unsigned pk = cvt_pk_bf16(a, b);
                Bs[(c16 * 8 + 2 * q) * LDR + r] = (bf16_t)(pk & 0xffffu); Bs[(c16 * 8 + 2 * q + 1) * LDR + r] = (bf16_t)(pk >> 16); } }
        LDS_WAIT(); __syncthreads();
        f32x4 acc[8];
#pragma unroll
        for (int n = 0; n < 8; ++n) acc[n] = (f32x4){0.f, 0.f, 0.f, 0.f};
        const int nkk = (wave >> 1) + 1;
        for (int kk = 0; kk < nkk; ++kk) {
            const bf16x8 af = *(const LAS bf16x8*)(As + (16 * wave + fr) * LDR + 32 * kk + 8 * fq);
#pragma unroll
            for (int n = 0; n < 8; ++n) { const bf16x8 bfg = *(const LAS bf16x8*)(Bs + (16 * n + fr) * LDR + 32 * kk + 8 * fq);
                acc[n] = __builtin_amdgcn_mfma_f32_16x16x32_bf16(bfg, af, acc[n], 0, 0, 0); }
        }
        const int t = 16 * wave + fr, row = c * 128 + t; const float b = bs[g * 128 + t];
#pragma unroll
        for (int n = 0; n < 8; ++n) { const size_t o = (size_t)row * 2048 + g * 128 + 16 * n + 4 * fq; const u32x2 uw = *(const u32x2*)(ZU + o);
            f32x4 v; v[0] = bflo(uw.x) * (acc[n][0] + b); v[1] = bfhi(uw.x) * (acc[n][1] + b); v[2] = bflo(uw.y) * (acc[n][2] + b); v[3] = bfhi(uw.y) * (acc[n][3] + b);
            st_bf16x4(Y + o, v); }
    }
    __syncthreads();
}

__device__ __forceinline__ int vswz(int kidx, int d) {
    const int kt = kidx >> 4, ks = kt >> 1, half = kt & 1, fq = (kidx & 15) >> 2, i = kidx & 3, dt = d >> 4, fr = d & 15;
    return ((dt * 2 + ks) * 64 + fq * 16 + fr) * 8 + half * 4 + i;
}
__device__ __forceinline__ void phase_kvprep(const Params& P, int wg0, int nwg) {
    unsigned char* ws = P.ws;
    const int tid = otid(), lane = tid & 63, gwave = ((int)blockIdx.x - wg0) * 8 + (tid >> 6), nwaves = nwg * 8;
    const float* tmp = (const float*)(ws + O_KVTMP);
    for (int it = gwave; it < 2 * 2 * SEQ; it += nwaves) {
        const int b = it / (2 * SEQ), rem = it % (2 * SEQ);
        const float* src = tmp + ((size_t)(b * 2) * 2 * SEQ + rem) * 128; const f32x2 v = *(const f32x2*)(src + 2 * lane);
        const float rs = __builtin_amdgcn_rsqf(wave_sum(v[0] * v[0] + v[1] * v[1]) * (1.0f / 128.0f) + EPSF);
        const float* kn = P.k_norm + (b + 1) * 128;
        bf16_t* dst = (bf16_t*)(ws + (b ? O_KW : O_KS)) + (size_t)rem * 128;
        *(unsigned*)(dst + 2 * lane) = cvt_pk_bf16(v[0] * rs * kn[2 * lane], v[1] * rs * kn[2 * lane + 1]);
    }
    for (int it = gwave; it < 2 * 2 * (SEQ / 4); it += nwaves) {
        const int b = it / (2 * (SEQ / 4)), rem = it % (2 * (SEQ / 4)), g = rem / (SEQ / 4), p4 = rem % (SEQ / 4), pos = p4 * 4;
        const float* src = tmp + ((size_t)(b * 2 + 1) * 2 * SEQ + (size_t)g * SEQ + pos) * 128;
        bf16_t* dst = (bf16_t*)(ws + (b ? O_VW : O_VS)) + ((size_t)g * 128 + (pos >> 6)) * 8192;
#pragma unroll
        for (int hh = 0; hh < 2; ++hh) { const int d = lane + 64 * hh;
            u32x2 w; w.x = cvt_pk_bf16(src[d], src[128 + d]); w.y = cvt_pk_bf16(src[256 + d], src[384 + d]);
            *(u32x2*)(dst + vswz(pos & 63, d)) = w; }
    }
}
__device__ __forceinline__ void phase_cmpprep(const Params& P) {
    unsigned char* ws = P.ws;
    const int tid = otid(), lane = tid & 63, gwave = blockIdx.x * 8 + (tid >> 6), nwaves = gridDim.x * 8;
    const float* craw = (const float*)(ws + O_CRAW);
    for (int it = gwave; it < 1024; it += nwaves) {
        const f32x2 v = *(const f32x2*)(craw + (size_t)it * 128 + 2 * lane);
        const float rs = __builtin_amdgcn_rsqf(wave_sum(v[0] * v[0] + v[1] * v[1]) * (1.0f / 128.0f) + EPSF);
        *(unsigned*)((bf16_t*)(ws + O_KCMP) + (size_t)it * 128 + 2 * lane) = cvt_pk_bf16(v[0] * rs * P.k_norm[2 * lane], v[1] * rs * P.k_norm[2 * lane + 1]);
    }
    for (int it = gwave; it < 1024 / 4; it += nwaves) {
        const int r0 = it * 4, g = r0 >> 9, i0 = r0 & 511;
        const float* src = craw + (size_t)(1024 + r0) * 128;
        bf16_t* dst = (bf16_t*)(ws + O_VCMP) + ((size_t)g * 8 + (i0 >> 6)) * 8192;
#pragma unroll
        for (int hh = 0; hh < 2; ++hh) { const int d = lane + 64 * hh;
            u32x2 w; w.x = cvt_pk_bf16(src[d], src[128 + d]); w.y = cvt_pk_bf16(src[256 + d], src[384 + d]);
            *(u32x2*)(dst + vswz(i0 & 63, d)) = w; }
    }
}

constexpr int AT_PK = 8192, AT_SC = AT_PK + 32768, AT_MSK = AT_SC + 4096, AT_KV = 49152;
template <int MODE, bool FAR>
__device__ __forceinline__ void attn_block(const LAS unsigned char* Ks, const LAS unsigned char* Vs, const bf16x8 (&qf)[4], int dist0, int dstep, int wlimit, bool colok,
                                           const LAS float* biasl, float& m, float& l, f32x4 (&O)[8], float mfin, float linv, LAS float* pk, int lane) {
    const int fr = lane & 15, fq = lane >> 4;
    f32x4 s[4];
#pragma unroll
    for (int kt = 0; kt < 4; ++kt) s[kt] = (f32x4){0.f, 0.f, 0.f, 0.f};
    {
        bf16x8 kfa[4], kfb[4];
#define AT_LDK(dst, KK) _Pragma("unroll") for (int kt = 0; kt < 4; ++kt) dst[kt] = *(const LAS bf16x8*)(Ks + (16 * kt + fr) * 256 + (((4 * (KK) + fq) ^ fr) << 4))
#define AT_MMK(src, KK) _Pragma("unroll") for (int kt = 0; kt < 4; ++kt) s[kt] = __builtin_amdgcn_mfma_f32_16x16x32_bf16(src[kt], qf[KK], s[kt], 0, 0, 0)
        AT_LDK(kfa, 0); AT_LDK(kfb, 1);
        __builtin_amdgcn_sched_barrier(0);
        AT_MMK(kfa, 0); AT_LDK(kfa, 2);
        __builtin_amdgcn_sched_barrier(0);
        AT_MMK(kfb, 1); AT_LDK(kfb, 3);
        __builtin_amdgcn_sched_barrier(0);
        AT_MMK(kfa, 2);
        __builtin_amdgcn_sched_barrier(0);
        AT_MMK(kfb, 3);
        __builtin_amdgcn_sched_barrier(0);
#undef AT_LDK
#undef AT_MMK
    }
    bf16x8 vfa[4], vfb[4];
#define AT_LDV(dst, KS, DH) _Pragma("unroll") for (int d4 = 0; d4 < 4; ++d4) dst[d4] = *(const LAS bf16x8*)(Vs + (((4 * (DH) + d4) * 2 + (KS)) * 64 + lane) * 16)
#define AT_MMV(src, PB, DH) _Pragma("unroll") for (int d4 = 0; d4 < 4; ++d4) O[4 * (DH) + d4] = __builtin_amdgcn_mfma_f32_16x16x32_bf16(src[d4], PB, O[4 * (DH) + d4], 0, 0, 0)
    if (MODE != 0) { AT_LDV(vfa, 0, 0); }
    __builtin_amdgcn_sched_barrier(0);
    float ps = 0.f;
    if (FAR) {
        const float c = colok ? biasl[127 * 16] : -300.0f;
#pragma unroll
        for (int kt = 0; kt < 4; ++kt)
#pragma unroll
            for (int j = 0; j < 4; ++j) { float pv = __builtin_amdgcn_exp2f(s[kt][j] + c); if (MODE == 1) pv *= linv; s[kt][j] = pv; ps += pv; }
    } else {
        float bv[4][4];
#pragma unroll
        for (int kt = 0; kt < 4; ++kt)
#pragma unroll
            for (int j = 0; j < 4; ++j) { const int dist = dist0 - dstep * (16 * kt + 4 * fq + j); const int di = dist < 0 ? 0 : (dist > 127 ? 127 : dist); bv[kt][j] = biasl[di * 16]; }
        __builtin_amdgcn_sched_barrier(0);
#pragma unroll
        for (int kt = 0; kt < 4; ++kt)
#pragma unroll
            for (int j = 0; j < 4; ++j) { const int dist = dist0 - dstep * (16 * kt + 4 * fq + j);
                const bool ok = colok && dist >= 0 && dist < wlimit;
                float pv = __builtin_amdgcn_exp2f(ok ? s[kt][j] + bv[kt][j] : -300.0f); if (MODE == 1) pv *= linv; s[kt][j] = pv; ps += pv; }
    }
    if (MODE != 1) l += ps;
    if (MODE == 0) return;
    if (MODE == 1) {
#pragma unroll
        for (int kt = 0; kt < 4; ++kt)
#pragma unroll
            for (int j = 0; j < 4; ++j) { float v = s[kt][j]; v += __shfl_xor(v, 1); v += __shfl_xor(v, 2); v += __shfl_xor(v, 4);
                if ((fr & 7) == 0) pk[(fr >> 3) * 512 + 16 * kt + 4 * fq + j] = v; }
    }
    bf16x8 pb[2];
#pragma unroll
    for (int ks = 0; ks < 2; ++ks) {
        u32x4 pw; pw.x = cvt_pk_bf16(s[2 * ks][0], s[2 * ks][1]); pw.y = cvt_pk_bf16(s[2 * ks][2], s[2 * ks][3]);
        pw.z = cvt_pk_bf16(s[2 * ks + 1][0], s[2 * ks + 1][1]); pw.w = cvt_pk_bf16(s[2 * ks + 1][2], s[2 * ks + 1][3]);
        pb[ks] = __builtin_bit_cast(bf16x8, pw);
    }
    AT_LDV(vfb, 0, 1);
    __builtin_amdgcn_sched_barrier(0);
    AT_MMV(vfa, pb[0], 0); AT_LDV(vfa, 1, 0);
    __builtin_amdgcn_sched_barrier(0);
    AT_MMV(vfb, pb[0], 1); AT_LDV(vfb, 1, 1);
    __builtin_amdgcn_sched_barrier(0);
    AT_MMV(vfa, pb[1], 0);
    __builtin_amdgcn_sched_barrier(0);
    AT_MMV(vfb, pb[1], 1);
    __builtin_amdgcn_sched_barrier(0);
#undef AT_LDV
#undef AT_MMV
}

__device__ __forceinline__ int t5_bucket_dev(int n) {
    if (n < 16) return n;
    int b = 16;
    b += (n >= 19) + (n >= 21) + (n >= 24) + (n >= 27) + (n >= 31) + (n >= 35) + (n >= 40) + (n >= 46) + (n >= 52) + (n >= 59) + (n >= 67) + (n >= 77) + (n >= 87) + (n >= 99) + (n >= 113);
    return b;
}
__device__ __forceinline__ unsigned long long bit_range64(int a, int b) {
    if (a < 0) a = 0; if (b > 63) b = 63; if (b < a) return 0ull;
    const int n = b - a + 1; return (n >= 64 ? ~0ull : ((1ull << n) - 1ull)) << a;
}
__device__ __forceinline__ bool bit128(unsigned long long lo, unsigned long long hi, int j) { return (((j < 64 ? lo >> j : hi >> (j - 64))) & 1ull) != 0ull; }

__device__ __forceinline__ int first_bit128(unsigned long long lo, unsigned long long hi) { return lo ? __builtin_ctzll(lo) : (hi ? 64 + __builtin_ctzll(hi) : -1); }
template <int MODE, int KIND>
__device__ __forceinline__ void attn_stream(LAS unsigned char* lds, int& rb, unsigned long long mlo, unsigned long long mhi, const bf16_t* Kbase, const bf16_t* Vbase,
                                            const bf16x8 (&qf)[4], int tq, int t0, unsigned long long sel_lo, unsigned long long sel_hi, unsigned long long wsel_lo, unsigned long long wsel_hi,
                                            const LAS float* biasl, float& m, float& l, f32x4 (&O)[8], float mfin, float linv, LAS float* pk, int tid, int lane) {
    const int wave = __builtin_amdgcn_readfirstlane(tid >> 6);
    unsigned ksrc[2];
#pragma unroll
    for (int i = 0; i < 2; ++i) { const int sl = tid + 512 * i, r = sl >> 4, c = sl & 15; ksrc[i] = (unsigned)(r * 128 + ((c ^ (r & 15)) << 3)); }
#define AT_ISSUE(JB, RB) do { const bf16_t* kb_ = Kbase + (size_t)(JB) * 8192; LAS unsigned char* dst_ = lds + AT_KV + (RB) * 32768 + wave * 1024; \
        _Pragma("unroll") for (int i_ = 0; i_ < 2; ++i_) __builtin_amdgcn_global_load_lds((const unsigned*)(kb_ + ksrc[i_]), (LAS unsigned*)(dst_ + i_ * 8192), 16, 0, 0); \
        if (MODE != 0) { const bf16_t* vb_ = Vbase + (size_t)(JB) * 8192 + tid * 8; \
            _Pragma("unroll") for (int i_ = 0; i_ < 2; ++i_) __builtin_amdgcn_global_load_lds((const unsigned*)(vb_ + i_ * 4096), (LAS unsigned*)(dst_ + 16384 + i_ * 8192), 16, 0, 0); } } while (0)
    int j = first_bit128(mlo, mhi);
    if (j < 0) return;
    if (j < 64) mlo &= mlo - 1; else mhi &= mhi - 1;
    int jn = first_bit128(mlo, mhi);
    AT_ISSUE(j, rb);
    if (jn >= 0) { if (jn < 64) mlo &= mlo - 1; else mhi &= mhi - 1; AT_ISSUE(jn, (rb + 1) % 3); }
    while (j >= 0) {
        if (jn >= 0) { if (MODE == 0) asm volatile("s_waitcnt vmcnt(2)" ::: "memory"); else asm volatile("s_waitcnt vmcnt(4)" ::: "memory"); }
        else asm volatile("s_waitcnt vmcnt(0)" ::: "memory");
        asm volatile("s_waitcnt lgkmcnt(0)" ::: "memory");
        __builtin_amdgcn_s_barrier();
        asm volatile("" ::: "memory");
        const int jnn = first_bit128(mlo, mhi);
        if (jnn >= 0) { if (jnn < 64) mlo &= mlo - 1; else mhi &= mhi - 1; AT_ISSUE(jnn, (rb + 2) % 3); }
        if (KIND != 1 || bit128(wsel_lo, wsel_hi, j)) {
            const LAS unsigned char* Ks = lds + AT_KV + rb * 32768; const LAS unsigned char* Vs = Ks + 16384;
            const int dist0 = KIND == 0 ? tq - 31 - 1024 * j : tq - 64 * j;
            const bool colok = KIND == 1 ? bit128(sel_lo, sel_hi, j) : true;
            const bool far = KIND == 0 ? (t0 - 31 - 1024 * j - 1008 >= 127) : (KIND == 1 ? (t0 - 64 * j - 63 >= 127) : (t0 - 64 * j - 63 >= 127 && t0 + 15 - 64 * j <= 511));
            if (far) attn_block<MODE, true>(Ks, Vs, qf, dist0, KIND == 0 ? 16 : 1, KIND == 2 ? 512 : 0x7fffffff, colok, biasl, m, l, O, mfin, linv, pk + (KIND == 0 ? 64 * j : 0), lane);
            else attn_block<MODE, false>(Ks, Vs, qf, dist0, KIND == 0 ? 16 : 1, KIND == 2 ? 512 : 0x7fffffff, colok, biasl, m, l, O, mfin, linv, pk + (KIND == 0 ? 64 * j : 0), lane);
        }
        rb = (rb + 1) % 3; j = jn; jn = jnn;
    }
#undef AT_ISSUE
}

__device__ __forceinline__ void phase_attn(const Params& P, LAS unsigned char* lds, int jl  ) {
    unsigned char* ws = P.ws;
    const int tid = otid(), lane = tid & 63, wave = __builtin_amdgcn_readfirstlane(tid >> 6), fr = lane & 15, fq = lane >> 4;
    LAS float* biasT = (LAS float*)lds;
    LAS float* pk = (LAS float*)(lds + AT_PK) + wave * 1024;
    LAS float* sc = (LAS float*)(lds + AT_SC) + wave * 128;
    LAS unsigned long long* msk = (LAS unsigned long long*)(lds + AT_MSK);
    __syncthreads();
    for (int i = tid; i < 2048; i += NTHREADS) biasT[i] = P.rel_bias[t5_bucket_dev(i >> 4) * 16 + (i & 15)] * 1.4426950408889634f;
    LDS_WAIT(); __syncthreads();
    const bf16_t* Q = (const bf16_t*)(ws + O_ZU); const float* gates = (const float*)(ws + O_GATES); bf16_t* Y = (bf16_t*)(ws + O_Y);
    const float* qn = P.b_q_norm + jl * 128;
    const int h = fr & 7;
    int buf = 0;
    for (int wg = blockIdx.x; wg < 256; wg += gridDim.x) {
        for (int it = 0; it < 4; ++it) {
            const int ti = (it & 2) ? 511 - wg : wg, g = it & 1, t0 = 16 * ti;
            const int tq = t0 + 2 * wave + (fr >> 3), head = g * 8 + h;
            const LAS float* biasl = biasT + head;
            const bf16_t* KS = (const bf16_t*)(ws + O_KS) + (size_t)g * SEQ * 128; const bf16_t* VS = (const bf16_t*)(ws + O_VS) + (size_t)g * SEQ * 128;
            const bf16_t* KW = (const bf16_t*)(ws + O_KW) + (size_t)g * SEQ * 128; const bf16_t* VW = (const bf16_t*)(ws + O_VW) + (size_t)g * SEQ * 128;
            const bf16_t* KC = (const bf16_t*)(ws + O_KCMP) + (size_t)g * 512 * 128; const bf16_t* VC = (const bf16_t*)(ws + O_VCMP) + (size_t)g * 512 * 128;
            bf16x8 qf[4];
            {
                const bf16_t* qp = Q + (size_t)tq * 2048 + head * 128 + 8 * fq; float qv[4][8]; float sq = 0.f;
#pragma unroll
                for (int kk = 0; kk < 4; ++kk) { const u32x4 w = *(const u32x4*)(qp + 32 * kk); const unsigned ww[4] = {w.x, w.y, w.z, w.w};
#pragma unroll
                    for (int e = 0; e < 4; ++e) { qv[kk][2 * e] = bflo(ww[e]); qv[kk][2 * e + 1] = bfhi(ww[e]); sq += qv[kk][2 * e] * qv[kk][2 * e] + qv[kk][2 * e + 1] * qv[kk][2 * e + 1]; } }
                sq += __shfl_xor(sq, 16); sq += __shfl_xor(sq, 32);
                const float rs = __builtin_amdgcn_rsqf(sq * (1.0f / 128.0f) + EPSF) * (0.08838834764831845f * 1.4426950408889634f);
#pragma unroll
                for (int kk = 0; kk < 4; ++kk) { const f32x4 n0 = *(const f32x4*)(qn + 32 * kk + 8 * fq), n1 = *(const f32x4*)(qn + 32 * kk + 8 * fq + 4); u32x4 w;
                    w.x = cvt_pk_bf16(qv[kk][0] * rs * n0[0], qv[kk][1] * rs * n0[1]); w.y = cvt_pk_bf16(qv[kk][2] * rs * n0[2], qv[kk][3] * rs * n0[3]);
                    w.z = cvt_pk_bf16(qv[kk][4] * rs * n1[0], qv[kk][5] * rs * n1[1]); w.w = cvt_pk_bf16(qv[kk][6] * rs * n1[2], qv[kk][7] * rs * n1[3]);
                    qf[kk] = __builtin_bit_cast(bf16x8, w); }
            }
            const float g_c = gates[(size_t)tq * 48 + head * 3 + 0], g_s = gates[(size_t)tq * 48 + head * 3 + 1], g_w = gates[(size_t)tq * 48 + head * 3 + 2];
            u32x2 OT[8]; f32x4 O[8];
#pragma unroll
            for (int dt = 0; dt < 8; ++dt) { OT[dt] = (u32x2){0u, 0u}; O[dt] = (f32x4){0.f, 0.f, 0.f, 0.f}; }
#pragma unroll
            for (int e = 0; e < 16; ++e) pk[lane + 64 * e] = 0.f;
            LDS_WAIT();
            {
                const int tmax = t0 + 15, kmaxT = tmax >= 31 ? (tmax - 31) >> 4 : -1, nb = kmaxT >= 0 ? (kmaxT >> 6) + 1 : 0;
                const unsigned long long cm = nb ? ((1ull << nb) - 1ull) : 0ull;
                float m = -1e30f, l = 0.f;
                attn_stream<0, 0>(lds, buf, cm, 0ull, KC, VC, qf, tq, t0, 0ull, 0ull, 0ull, 0ull, biasl, m, l, O, 0.f, 0.f, pk, tid, lane);
                l += __shfl_xor(l, 16); l += __shfl_xor(l, 32);
                const float linv = l > 0.f ? 1.0f / l : 0.f;
                attn_stream<1, 0>(lds, buf, cm, 0ull, KC, VC, qf, tq, t0, 0ull, 0ull, 0ull, 0ull, biasl, m, l, O, m, linv, pk, tid, lane);
#pragma unroll
                for (int dt = 0; dt < 8; ++dt) { OT[dt].x = cvt_pk_bf16(O[dt][0] * g_c, O[dt][1] * g_c); OT[dt].y = cvt_pk_bf16(O[dt][2] * g_c, O[dt][3] * g_c); }
            }
            LDS_WAIT();
            unsigned long long ma0 = 0, ma1 = 0, mb0 = 0, mb1 = 0;
#pragma unroll
            for (int q = 0; q < 2; ++q) {
                const int tqq = t0 + 2 * wave + q, cur = tqq >> 6; const LAS float* pq = pk + q * 512;
                float myscore[2];
#pragma unroll
                for (int e = 0; e < 2; ++e) { const int jb = lane + 64 * e;
                    const float imp = pq[4 * jb] + pq[4 * jb + 1] + pq[4 * jb + 2] + 0.5f * pq[4 * jb + 3] + (jb > 0 ? 0.5f * pq[4 * jb - 1] : 0.f);
                    const bool forced = (jb == 0) || (jb == cur) || (jb == cur - 1);
                    const float scv = forced ? 3.0e38f : (jb <= cur ? imp : -1.0f);
                    myscore[e] = scv; sc[jb] = scv; }
                LDS_WAIT();
                int cnt0 = 0, cnt1 = 0;
                for (int jj = 0; jj < 128; jj += 4) { const f32x4 v = *(const LAS f32x4*)(sc + jj);
#pragma unroll
                    for (int e = 0; e < 4; ++e) { const int jo = jj + e;
                        cnt0 += (v[e] > myscore[0] || (v[e] == myscore[0] && jo < lane)) ? 1 : 0;
                        cnt1 += (v[e] > myscore[1] || (v[e] == myscore[1] && jo < lane + 64)) ? 1 : 0; } }
                const unsigned long long k0 = __ballot(cnt0 < 16 && lane <= cur), k1 = __ballot(cnt1 < 16 && lane + 64 <= cur);
                if (q == 0) { ma0 = k0; ma1 = k1; } else { mb0 = k0; mb1 = k1; }
                LDS_WAIT();
            }
            __syncthreads();
            if (lane == 0) { msk[(2 * wave) * 2] = ma0; msk[(2 * wave) * 2 + 1] = ma1; msk[(2 * wave + 1) * 2] = mb0; msk[(2 * wave + 1) * 2 + 1] = mb1; }
            LDS_WAIT(); __syncthreads();
            unsigned long long ulo = 0, uhi = 0;
#pragma unroll
            for (int q = 0; q < 16; ++q) { ulo |= msk[2 * q]; uhi |= msk[2 * q + 1]; }
            ulo = ((unsigned long long)__builtin_amdgcn_readfirstlane((unsigned)(ulo >> 32)) << 32) | (unsigned)__builtin_amdgcn_readfirstlane((unsigned)ulo);
            uhi = ((unsigned long long)__builtin_amdgcn_readfirstlane((unsigned)(uhi >> 32)) << 32) | (unsigned)__builtin_amdgcn_readfirstlane((unsigned)uhi);
            {
                float m = -1e30f, l = 0.f;
#pragma unroll
                for (int dt = 0; dt < 8; ++dt) O[dt] = (f32x4){0.f, 0.f, 0.f, 0.f};
                const unsigned long long sl = fr < 8 ? ma0 : mb0, sh = fr < 8 ? ma1 : mb1;
                attn_stream<2, 1>(lds, buf, ulo, uhi, KS, VS, qf, tq, t0, sl, sh, ma0 | mb0, ma1 | mb1, biasl, m, l, O, 0.f, 0.f, pk, tid, lane);
                l += __shfl_xor(l, 16); l += __shfl_xor(l, 32);
                const float sc_ = g_s / l;
#pragma unroll
                for (int dt = 0; dt < 8; ++dt) { OT[dt].x = cvt_pk_bf16(bflo(OT[dt].x) + O[dt][0] * sc_, bfhi(OT[dt].x) + O[dt][1] * sc_); OT[dt].y = cvt_pk_bf16(bflo(OT[dt].y) + O[dt][2] * sc_, bfhi(OT[dt].y) + O[dt][3] * sc_); }
            }
            {
                float m = -1e30f, l = 0.f;
#pragma unroll
                for (int dt = 0; dt < 8; ++dt) O[dt] = (f32x4){0.f, 0.f, 0.f, 0.f};
                const int jb0 = t0 >= 511 ? (t0 - 511) >> 6 : 0, jb1 = (t0 + 15) >> 6;
                attn_stream<2, 2>(lds, buf, bit_range64(jb0, jb1), bit_range64(jb0 - 64, jb1 - 64), KW, VW, qf, tq, t0, 0ull, 0ull, 0ull, 0ull, biasl, m, l, O, 0.f, 0.f, pk, tid, lane);
                l += __shfl_xor(l, 16); l += __shfl_xor(l, 32);
                const float sc_ = g_w / l;
#pragma unroll
                for (int dt = 0; dt < 8; ++dt) { OT[dt].x = cvt_pk_bf16(bflo(OT[dt].x) + O[dt][0] * sc_, bfhi(OT[dt].x) + O[dt][1] * sc_); OT[dt].y = cvt_pk_bf16(bflo(OT[dt].y) + O[dt][2] * sc_, bfhi(OT[dt].y) + O[dt][3] * sc_); }
            }
            {
                bf16_t* yp = Y + (size_t)tq * 2048 + head * 128 + 4 * fq;
#pragma unroll
                for (int dt = 0; dt < 8; ++dt) *(u32x2*)(yp + 16 * dt) = OT[dt];
            }
        }
    }
    __syncthreads();
}

#define XB_TMO      128
#define XB_XCNT(j)  (256  + 64 * (j))
#define XB_XSUB(j)  (1280 + 64 * (j))
#define XB_XGEN(j)  (2304 + 64 * (j))
#define XB_TOP      3328
#define XB_TOPGEN   3392
#define XB_SPIN_CAP (1u << 18)
__device__ __forceinline__ unsigned xb_ld(unsigned* p)              { return __hip_atomic_load(p, __ATOMIC_RELAXED, __HIP_MEMORY_SCOPE_AGENT); }
__device__ __forceinline__ unsigned xb_add(unsigned* p, unsigned v) { return __hip_atomic_fetch_add(p, v, __ATOMIC_RELAXED, __HIP_MEMORY_SCOPE_AGENT); }
__device__ __forceinline__ unsigned xb_xcc_id() { return (unsigned)__builtin_amdgcn_s_getreg((3 << 11) | 20) & 0xFu; }
#define XB_SPIN(cond, bar) do { unsigned _sp = 0; while (cond) { __builtin_amdgcn_s_sleep(1); \
    if ((++_sp & 255u) == 0u) { if (xb_ld(&(bar)[XB_TMO])) break; if (_sp > XB_SPIN_CAP) { atomicAdd(&(bar)[XB_TMO], 1u); break; } } } } while (0)
struct XcdBarrier { unsigned* bar; unsigned x; volatile LAS unsigned* st; };
__device__ __forceinline__ XcdBarrier xcd_barrier_post(unsigned* bar, volatile LAS unsigned* st) {
    XcdBarrier b; b.bar = bar; b.x = xb_xcc_id(); b.st = st;
    if (threadIdx.x == 0) (void)xb_add(&bar[XB_XCNT(b.x)], 1u);
    return b;
}
__device__ __forceinline__ void xcd_barrier_complete(unsigned* bar, unsigned x, unsigned& nloc, unsigned& nx) {
    const unsigned G = gridDim.x * gridDim.y * gridDim.z;
    unsigned sum, cnt, mine, sp = 0u;
    for (;;) {
        sum = 0u; cnt = 0u; mine = 0u;
#pragma unroll
        for (unsigned j = 0; j < 16; ++j) { const unsigned c = xb_ld(&bar[XB_XCNT(j)]); sum += c; cnt += (c > 0u) ? 1u : 0u; mine = (j == x) ? c : mine; }
        if (sum == G) break;
        __builtin_amdgcn_s_sleep(1);
        if ((++sp & 255u) == 0u) { if (xb_ld(&bar[XB_TMO])) break; if (sp > XB_SPIN_CAP) { atomicAdd(&bar[XB_TMO], 1u); break; } }
    }
    nloc = mine > 0u ? mine : 1u; nx = cnt > 0u ? cnt : 1u;
}
__device__ __forceinline__ void xcd_barrier(const XcdBarrier& b) {
    asm volatile("s_waitcnt vmcnt(0)" ::: "memory");
    __syncthreads();
    if (threadIdx.x == 0) {
        unsigned* bar = b.bar;
        __builtin_amdgcn_s_waitcnt(0);
        unsigned nloc = b.st[0], nx = b.st[1];
        if (nloc == 0u) { xcd_barrier_complete(bar, b.x, nloc, nx); b.st[0] = nloc; b.st[1] = nx; }
        const unsigned old = xb_add(&bar[XB_XSUB(b.x)], 1u);
        const unsigned gen = old / nloc;
        if (old + 1u == (gen + 1u) * nloc) {
            __builtin_amdgcn_fence(__ATOMIC_RELEASE, "agent");
            asm volatile("s_waitcnt vmcnt(0)" ::: "memory");
            const unsigned og = xb_add(&bar[XB_TOP], 1u);
            const unsigned tg = og / nx;
            if (og + 1u == (tg + 1u) * nx) xb_add(&bar[XB_TOPGEN], 1u);
            else XB_SPIN(xb_ld(&bar[XB_TOPGEN]) == tg, bar);
            __builtin_amdgcn_fence(__ATOMIC_ACQUIRE, "agent");
            xb_add(&bar[XB_XGEN(b.x)], 1u);
            asm volatile("s_waitcnt vmcnt(0)" ::: "memory");
        } else {
            XB_SPIN(xb_ld(&bar[XB_XGEN(b.x)]) == gen, bar);
            __builtin_amdgcn_fence(__ATOMIC_ACQUIRE, "agent");
            asm volatile("s_waitcnt vmcnt(0)" ::: "memory");
        }
    }
    __syncthreads();
}

__global__ void __launch_bounds__(NTHREADS, 2) yoco_fwd(Params P) {
    extern __shared__ __attribute__((aligned(16))) unsigned char lds_raw[];
    LAS unsigned char* lds = (LAS unsigned char*)lds_raw;
    cg::grid_group grid = cg::this_grid();
    unsigned char* ws = P.ws;
    const int G = gridDim.x, bid = blockIdx.x;
    float* SS = (float*)(ws + O_SS);
    bf16_t* XB0 = (bf16_t*)(ws + O_XB); bf16_t* XB1 = XB0 + (size_t)SEQ * DM;
    pg8::StaticOrder S;

    volatile LAS unsigned* bst = (volatile LAS unsigned*)(lds + 147456);
    if (threadIdx.x < 4) bst[threadIdx.x] = 0u;
    __syncthreads();
    const XcdBarrier xbar = xcd_barrier_post((unsigned*)(ws + O_BAR), bst);
    phase_prologue(P, lds);
    grid.sync();

    for (int layer = 0; layer < 4; ++layer) {
        bf16_t* xcur = (layer & 1) ? XB1 : XB0; bf16_t* xoth = (layer & 1) ? XB0 : XB1;
        const float* ss_mix = SS + (size_t)(3 * layer) * SEQ * 32; float* ss_ffn = SS + (size_t)(3 * layer + 1) * SEQ * 32; float* ss_ple = SS + (size_t)(3 * layer + 2) * SEQ * 32;
        float* ss_next = layer < 3 ? SS + (size_t)(3 * layer + 3) * SEQ * 32 : nullptr;
        const float* xres0 = layer == 0 ? P.x : P.out;
        if (layer < 2) {
            {
                pg8::Gemm g{xcur, (const bf16_t*)(ws + O_WAIN) + (size_t)layer * 4096 * 2048, SEQ, 4096, 2048, 2048}; S.init(SEQ, 4096, G, bid);
                Epi<EP_GMLP_IN> E; E.p = EpiP{ss_mix, nullptr, nullptr, nullptr, nullptr, (bf16_t*)(ws + O_ZU), (bf16_t*)(ws + O_ZV), nullptr, nullptr, nullptr, (float*)(ws + O_SSV) + (size_t)layer * SEQ * 32};
                pg8::gemm_phase(lds, g, S, E);
            }
            xcd_barrier(xbar);
            phase_sgu(P, lds, layer);
            xcd_barrier(xbar);
            {
                pg8::Gemm g{(const bf16_t*)(ws + O_Y), (const bf16_t*)(ws + O_WAOUT) + (size_t)layer * 2048 * 2048, SEQ, 2048, 2048, 2048}; S.init(SEQ, 2048, G, bid);
                Epi<EP_RESID> E; E.p = EpiP{nullptr, ss_ffn, nullptr, nullptr, xoth, nullptr, xcur, nullptr, nullptr, nullptr, nullptr};
                pg8::gemm_phase(lds, g, S, E);
            }
            xcd_barrier(xbar);
        } else {
            const int j = layer - 2;
            if (j > 0) {
                pg8::Gemm g{xcur, (const bf16_t*)(ws + O_WBIN) + (size_t)j * NQP * 2048, SEQ, NQP, 2048, 2048}; S.init(SEQ, NQP, G, bid);
                Epi<EP_QG> E; E.p = EpiP{ss_mix, nullptr, nullptr, nullptr, nullptr, (bf16_t*)(ws + O_ZU), nullptr, (float*)(ws + O_GATES), nullptr, nullptr, nullptr};
                pg8::gemm_phase(lds, g, S, E);
                if (G == 256 && bid >= 32) {
                    const int tidc = otid();
                    convert_set(P, lds, 5, (bid - 32) * 8 + (tidc >> 6), 224 * 8, tidc & 63, tidc >> 6);
                }
                xcd_barrier(xbar);
            }
            phase_attn(P, lds, j);
            xcd_barrier(xbar);
            {
                pg8::Gemm g{(const bf16_t*)(ws + O_Y), (const bf16_t*)(ws + O_WBOUT) + (size_t)j * 2048 * 2048, SEQ, 2048, 2048, 2048}; S.init(SEQ, 2048, G, bid);
                Epi<EP_RESID> E; E.p = EpiP{nullptr, ss_ffn, nullptr, nullptr, xoth, nullptr, xcur, nullptr, nullptr, nullptr, nullptr};
                pg8::gemm_phase(lds, g, S, E);
            }
            xcd_barrier(xbar);
        }
        {
            pg8::Gemm g{xoth, (const bf16_t*)(ws + O_WFIN) + (size_t)layer * 11264 * 2048, SEQ, 11264, 2048, 2048}; S.init(SEQ, 11264, G, bid);
            Epi<EP_FFN_IN> E; E.p = EpiP{ss_ffn, nullptr, nullptr, nullptr, nullptr, (bf16_t*)(ws + O_HID), nullptr, nullptr, nullptr, nullptr, nullptr};
            pg8::gemm_phase(lds, g, S, E);
            if (G == 256 && bid >= 128) {
                const int tidc = otid();
                convert_set(P, lds, 1 + layer, (bid - 128) * 8 + (tidc >> 6), 128 * 8, tidc & 63, tidc >> 6);
                __syncthreads();
            }
            pg8::Gemm g2{(const bf16_t*)(ws + O_PB) + (size_t)layer * SEQ * PLED, (const bf16_t*)(ws + O_WPW) + (size_t)layer * 2048 * 256, SEQ, 2048, 256, 256}; S.init(SEQ, 2048, G, bid);
            Epi<EP_PROJ> E2; E2.p = EpiP{nullptr, nullptr, nullptr, nullptr, nullptr, (bf16_t*)(ws + O_PROJ), nullptr, nullptr, nullptr, nullptr, nullptr};
            pg8::gemm_phase(lds, g2, S, E2);
        }
        xcd_barrier(xbar);
        {
            pg8::Gemm g{(const bf16_t*)(ws + O_HID), (const bf16_t*)(ws + O_WFOUT) + (size_t)layer * 2048 * FFD, SEQ, 2048, FFD, FFD}; S.init(SEQ, 2048, G, bid);
            Epi<EP_RESID> E; E.p = EpiP{nullptr, ss_ple, nullptr, nullptr, xcur, nullptr, xoth, nullptr, nullptr, nullptr, nullptr};
            pg8::gemm_phase(lds, g, S, E);
        }
        xcd_barrier(xbar);
        {
            pg8::Gemm g{xcur, (const bf16_t*)(ws + O_WPG) + (size_t)layer * 2048 * 2048, SEQ, 2048, 2048, 2048}; S.init(SEQ, 2048, G, bid);
            Epi<EP_PLE> E; E.p = EpiP{ss_ple, ss_next, nullptr, layer == 3 ? P.out : nullptr, layer == 3 ? nullptr : xoth, nullptr, xcur, nullptr, (const bf16_t*)(ws + O_PROJ), nullptr, nullptr};
            pg8::gemm_phase(lds, g, S, E);
        }
        xcd_barrier(xbar);
        if (layer == 1) {
            {
                pg8::Gemm g{xoth, (const bf16_t*)(ws + O_WKV), SEQ, NKVC, 2048, 2048}; S.init(SEQ, NKVC, G, bid);
                Epi<EP_KV> E; E.p = EpiP{ss_next, nullptr, nullptr, nullptr, nullptr, (bf16_t*)(ws + O_KC), (bf16_t*)(ws + O_VC), (float*)(ws + O_KVTMP), nullptr, nullptr, nullptr};
                pg8::gemm_phase(lds, g, S, E);
            }
            xcd_barrier(xbar);
            if (G != 256) phase_kvprep(P, 0, G);
            if (bid < 8) {
                pg8::Gemm g{(const bf16_t*)(ws + O_KC), (const bf16_t*)(ws + O_WC1), 1024, 256, 4096, 2048}; S.init(1024, 256, G, bid);
                Epi<EP_C1> E; E.p = EpiP{nullptr, nullptr, nullptr, nullptr, nullptr, (bf16_t*)(ws + O_HK), nullptr, nullptr, nullptr, (const float*)(ws + O_CB), nullptr};
                pg8::gemm_phase(lds, g, S, E);
                pg8::Gemm g2{(const bf16_t*)(ws + O_VC), (const bf16_t*)(ws + O_WC1) + 256ull * 4096, 1024, 256, 4096, 2048}; S.init(1024, 256, G, (bid + G - 4) % G);
                Epi<EP_C1> E2; E2.p = EpiP{nullptr, nullptr, nullptr, nullptr, nullptr, (bf16_t*)(ws + O_HV), nullptr, nullptr, nullptr, (const float*)(ws + O_CB) + 256, nullptr};
                pg8::gemm_phase(lds, g2, S, E2);
            } else {
                pg8::Gemm g{xoth, (const bf16_t*)(ws + O_WBIN), SEQ, NQP, 2048, 2048}; S.init(SEQ, NQP, G - 8, bid - 8);
                Epi<EP_QG> E; E.p = EpiP{ss_next, nullptr, nullptr, nullptr, nullptr, (bf16_t*)(ws + O_ZU), nullptr, (float*)(ws + O_GATES), nullptr, nullptr, nullptr};
                pg8::gemm_phase(lds, g, S, E);
                if (G == 256 && bid >= 48) phase_kvprep(P, 48, 208);
            }
            xcd_barrier(xbar);
            {
                pg8::Gemm g{(const bf16_t*)(ws + O_HK), (const bf16_t*)(ws + O_WC2), 1024, 256, 256, 256}; S.init(1024, 256, G, bid);
                Epi<EP_C2> E; E.p = EpiP{nullptr, nullptr, nullptr, nullptr, nullptr, nullptr, nullptr, (float*)(ws + O_CRAW), nullptr, nullptr, nullptr};
                pg8::gemm_phase(lds, g, S, E);
                pg8::Gemm g2{(const bf16_t*)(ws + O_HV), (const bf16_t*)(ws + O_WC2) + 256ull * 256, 1024, 256, 256, 256}; S.init(1024, 256, G, (bid + G - 4) % G);
                Epi<EP_C2> E2; E2.p = EpiP{nullptr, nullptr, nullptr, nullptr, nullptr, nullptr, nullptr, (float*)(ws + O_CRAW) + 1024 * 128, nullptr, nullptr, nullptr};
                pg8::gemm_phase(lds, g2, S, E2);
            }
            xcd_barrier(xbar);
            phase_cmpprep(P);
            xcd_barrier(xbar);
        }
    }
}

extern "C" void kernel_launch(void* const* d_in, const int* in_sizes, int n_in, void* d_out, int out_size, void* d_ws, size_t ws_size, hipStream_t stream) {
    static int grid = 0;
    if (grid == 0) {
        if (n_in != 27 || ws_size < O_END) { fprintf(stderr, "kernel_launch: unexpected problem (n_in %d, ws %zu, need %zu)\n", n_in, ws_size, (size_t)O_END); grid = -1; return; }
        int dev = 0, cus = 0, per_cu = 0;
        hipGetDevice(&dev); hipDeviceGetAttribute(&cus, hipDeviceAttributeMultiprocessorCount, dev);
        if (hipFuncSetAttribute((const void*)yoco_fwd, hipFuncAttributeMaxDynamicSharedMemorySize, LDS_BYTES) != hipSuccess) { fprintf(stderr, "kernel_launch: hipFuncSetAttribute failed\n"); grid = -1; return; }
        if (hipOccupancyMaxActiveBlocksPerMultiprocessor(&per_cu, (const void*)yoco_fwd, NTHREADS, LDS_BYTES) != hipSuccess || per_cu < 1) { fprintf(stderr, "kernel_launch: occupancy query gave %d\n", per_cu); per_cu = 1; }
        (void)hipGetLastError();
        grid = cus * 1;
        if (grid > 256) grid = 256;
    }
    if (grid < 0) return;
    Params p{};
    const float** pp = (const float**)&p;
    for (int i = 0; i < 27; ++i) pp[i] = (const float*)d_in[i];
    p.out = (float*)d_out; p.ws = (unsigned char*)d_ws;
    if (hipMemsetAsync((unsigned char*)d_ws + O_BAR, 0, BAR_BYTES, stream) != hipSuccess) { fprintf(stderr, "kernel_launch: memset of the barrier words failed\n"); return; }
    void* args[] = {&p};
    hipError_t e = hipLaunchCooperativeKernel((const void*)yoco_fwd, dim3(grid), dim3(NTHREADS), args, LDS_BYTES, stream);
    if (e != hipSuccess) fprintf(stderr, "cooperative launch failed: %s (grid %d)\n", hipGetErrorString(e), grid);
}
```

```cpp
#include <hip/hip_runtime.h>
#include <hip/hip_cooperative_groups.h>
#include <cstdio>
#include <cstdint>
namespace cg = cooperative_groups;

#define LAS __attribute__((address_space(3)))
typedef unsigned short bf16_t;
typedef short bf16x8 __attribute__((ext_vector_type(8)));
typedef float f32x4 __attribute__((ext_vector_type(4)));
typedef float f32x2 __attribute__((ext_vector_type(2)));
typedef unsigned u32x4 __attribute__((ext_vector_type(4)));
typedef unsigned u32x2 __attribute__((ext_vector_type(2)));

constexpr int SEQ = 8192, DM = 2048, FFD = 5632, PLED = 256, NQP = 2304, NKVC = 1536;
constexpr float EPSF = 1e-6f;
constexpr int NTHREADS = 512;
constexpr int LDS_BYTES = 147456 + 64;

constexpr size_t O_WAIN  = 0;
constexpr size_t O_WAOUT = O_WAIN  + 2ull * 4096 * 2048 * 2;
constexpr size_t O_WFIN  = O_WAOUT + 2ull * 2048 * 2048 * 2;
constexpr size_t O_WFOUT = O_WFIN  + 4ull * 11264 * 2048 * 2;
constexpr size_t O_WPG   = O_WFOUT + 4ull * 2048 * 5632 * 2;
constexpr size_t O_WPW   = O_WPG   + 4ull * 2048 * 2048 * 2;
constexpr size_t O_WKV   = O_WPW   + 4ull * 2048 * 256 * 2;
constexpr size_t O_WBIN  = O_WKV   + 1536ull * 2048 * 2;
constexpr size_t O_WBOUT = O_WBIN  + 2ull * 2304 * 2048 * 2;
constexpr size_t O_WC1   = O_WBOUT + 2ull * 2048 * 2048 * 2;
constexpr size_t O_WC2   = O_WC1   + 2ull * 256 * 4096 * 2;
constexpr size_t O_WSB   = O_WC2   + 2ull * 256 * 256 * 2;
constexpr size_t O_XB    = O_WSB   + 2ull * 16 * 128 * 128 * 2;
constexpr size_t O_ZU    = O_XB    + 2ull * 8192 * 2048 * 2;
constexpr size_t O_ZV    = O_ZU    + 8192ull * 2048 * 2;
constexpr size_t O_Y     = O_ZV    + 8192ull * 2048 * 2;
constexpr size_t O_HID   = O_Y     + 8192ull * 2048 * 2;
constexpr size_t O_PROJ  = O_HID   + 8192ull * 5632 * 2;
constexpr size_t O_PB    = O_PROJ  + 8192ull * 2048 * 2;
constexpr size_t O_GATES = O_PB    + 4ull * 8192 * 256 * 2;
constexpr size_t O_KC    = O_GATES + 8192ull * 48 * 4;
constexpr size_t O_VC    = O_KC    + 2ull * 8192 * 128 * 2 + 16384;
constexpr size_t O_KVTMP = O_VC    + 2ull * 8192 * 128 * 2 + 16384;
constexpr size_t O_KS    = O_KVTMP + 8ull * 8192 * 128 * 4;
constexpr size_t O_VS    = O_KS    + 2ull * 8192 * 128 * 2;
constexpr size_t O_KW    = O_VS    + 2ull * 8192 * 128 * 2;
constexpr size_t O_VW    = O_KW    + 2ull * 8192 * 128 * 2;
constexpr size_t O_HK    = O_VW    + 2ull * 8192 * 128 * 2;
constexpr size_t O_HV    = O_HK    + 1024ull * 256 * 2;
constexpr size_t O_CRAW  = O_HV    + 1024ull * 256 * 2;
constexpr size_t O_KCMP  = O_CRAW  + 2ull * 1024 * 128 * 4;
constexpr size_t O_VCMP  = O_KCMP  + 2ull * 512 * 128 * 2;
constexpr size_t O_SS    = O_VCMP  + 2ull * 512 * 128 * 2;
constexpr size_t O_SSV   = O_SS    + 13ull * 8192 * 32 * 4;
constexpr size_t O_CB    = O_SSV   + 2ull * 8192 * 32 * 4;
constexpr size_t O_BAR   = O_CB    + 2048;
constexpr size_t BAR_BYTES = 16384;
constexpr size_t O_END   = O_BAR   + BAR_BYTES;

__device__ __forceinline__ unsigned cvt_pk_bf16(float lo, float hi) { unsigned r; asm volatile("v_cvt_pk_bf16_f32 %0, %1, %2" : "=v"(r) : "v"(lo), "v"(hi)); return r; }
__device__ __forceinline__ float bf2f(unsigned short b) { return __uint_as_float(((unsigned)b) << 16); }
__device__ __forceinline__ float bflo(unsigned w) { return __uint_as_float(w << 16); }
__device__ __forceinline__ float bfhi(unsigned w) { return __uint_as_float(w & 0xffff0000u); }
typedef _Float16 f16x8 __attribute__((ext_vector_type(8)));
typedef _Float16 f16x2 __attribute__((ext_vector_type(2)));
__device__ __forceinline__ unsigned cvt_pk_f16(float lo, float hi) { const f16x2 v = {(_Float16)lo, (_Float16)hi}; return __builtin_bit_cast(unsigned, v); }
__device__ __forceinline__ float h2lo(unsigned w) { const f16x2 v = __builtin_bit_cast(f16x2, w); return (float)v[0]; }
__device__ __forceinline__ float h2hi(unsigned w) { const f16x2 v = __builtin_bit_cast(f16x2, w); return (float)v[1]; }
__device__ __forceinline__ float fexp(float x) { return __builtin_amdgcn_exp2f(x * 1.4426950408889634f); }
__device__ __forceinline__ float sigm(float x) { return __builtin_amdgcn_rcpf(1.0f + fexp(-x)); }
__device__ __forceinline__ float gelu_t(float x) { const float z = 1.5957691216057308f * (x + 0.044715f * x * x * x); return x * sigm(z); }
__device__ __forceinline__ float wave_sum(float v) {
#pragma unroll
    for (int o = 1; o < 64; o <<= 1) v += __shfl_xor(v, o);
    return v;
}
#define LDS_WAIT() asm volatile("s_waitcnt lgkmcnt(0)" ::: "memory")
__device__ __forceinline__ int otid() { int t; asm volatile("v_mov_b32 %0, %1" : "=v"(t) : "v"((int)threadIdx.x)); return t; }

namespace pg8 {
constexpr int BM = 256, BK = 64, HALF = 128, HTB = HALF * BK * 2, STAGE_BYTES = 8 * HTB, NXCD = 8, WGM = 8;
__host__ __device__ __forceinline__ int lds_byte(int r, int c) { const int st = (r >> 4) * 2 + (c >> 5), rr = r & 15, cc = c & 31, ob = rr * 64 + cc * 2; return st * 1024 + (ob ^ (((ob >> 9) & 1) << 5)); }
__host__ __device__ __forceinline__ void stage_rc(int b, int& R, int& C) { const int st = b / 1024, sb = b % 1024, swz = sb ^ (((sb >> 9) & 1) << 5); R = (st >> 1) * 16 + swz / 64; C = (st & 1) * 32 + (swz % 64) / 2; }
struct Unit { int pm, pn; };
struct Gemm { const bf16_t* A; const bf16_t* Bt; int M, N, K, lda; };
struct StaticOrder {
    int nM, nN, nwg, G, c;
    __device__ void init(int M, int N, int G_, int c_) { nM = M / BM; nN = N / BM; nwg = nM * nN; G = G_; c = c_; }
    __device__ bool next(int i, Unit& u) const {
        const long L = (long)i * G + c; if (L >= nwg) return false;
        int wgid = (int)L; { const int q = nwg / NXCD, r = nwg % NXCD, xcd = wgid % NXCD, off = wgid / NXCD; wgid = (xcd < r ? xcd * (q + 1) : r * (q + 1) + (xcd - r) * q) + off; }
        const int nig = WGM * nN, gid = wgid / nig, fm = gid * WGM, gsz = (nM - fm) < WGM ? (nM - fm) : WGM;
        u.pm = fm + ((wgid % nig) % gsz); u.pn = (wgid % nig) / gsz; return true;
    }
};
template <class Epi>
__device__ __forceinline__ void gemm_phase(LAS unsigned char* lds, const Gemm g, const StaticOrder& S, const Epi& E) {
    const int tid = otid(), wid = __builtin_amdgcn_readfirstlane(tid >> 6), lane = tid & 63, wr = wid >> 2, wc = wid & 3, fr = lane & 15, fq = lane >> 4;
    const int K = g.K, nt = K / BK;
    unsigned voffA[2], voffB[2];
#pragma unroll
    for (int i = 0; i < 2; ++i) { int R, C; stage_rc(tid * 16 + i * 8192, R, C);
        const int rho = R & 31, Rb = (R & ~31) + 8 * ((rho & 15) >> 2) + 4 * (rho >> 4) + (rho & 3);
        voffA[i] = (unsigned)(R * g.lda + C) * 2u; voffB[i] = (unsigned)(Rb * K + C) * 2u; }
    const size_t kstep = (size_t)(BK * 2);
    const size_t hstepA = (size_t)HALF * g.lda * 2, hstepB = (size_t)HALF * K * 2;
    const size_t tstepA = 2 * hstepA, tstepB = 2 * hstepB;
    const unsigned ldsw = (unsigned)wid * 1024u;
    const int aoff = lds_byte(wr * 64 + fr, fq * 8), boff = lds_byte(wc * 32 + fr, fq * 8);
#define PG8_SA(b, h) (((b) * 2 + (h)) * HTB)
#define PG8_SB(b, h) ((4 + (b) * 2 + (h)) * HTB)
#define PG8_STAGE(bufoff, gbase, voff) do { _Pragma("unroll") for (int _i = 0; _i < 2; ++_i) \
        __builtin_amdgcn_global_load_lds((const unsigned*)((const char*)(gbase) + (voff)[_i]), (LAS unsigned*)(lds + (bufoff) + ldsw + _i * 8192), 16, 0, 0); } while (0)
#define PG8_LDA(dst, b, h) do { _Pragma("unroll") for (int m = 0; m < 4; ++m) _Pragma("unroll") for (int k = 0; k < 2; ++k) dst[m][k] = *(const LAS bf16x8*)(lds + PG8_SA(b, h) + aoff + m * 2048 + k * 1024); } while (0)
#define PG8_LDB(dst, b, h) do { _Pragma("unroll") for (int n = 0; n < 2; ++n) _Pragma("unroll") for (int k = 0; k < 2; ++k) dst[n][k] = *(const LAS bf16x8*)(lds + PG8_SB(b, h) + boff + n * 2048 + k * 1024); } while (0)
#define PG8_MMA(ai, bj, At, Bt) do { __builtin_amdgcn_s_setprio(1); _Pragma("unroll") for (int m = 0; m < 4; ++m) _Pragma("unroll") for (int n = 0; n < 2; ++n) _Pragma("unroll") for (int k = 0; k < 2; ++k) \
        acc[ai][bj][m][n] = Epi::F16 ? __builtin_amdgcn_mfma_f32_16x16x32_f16(__builtin_bit_cast(f16x8, Bt[n][k]), __builtin_bit_cast(f16x8, At[m][k]), acc[ai][bj][m][n], 0, 0, 0) \
                                     : __builtin_amdgcn_mfma_f32_16x16x32_bf16(Bt[n][k], At[m][k], acc[ai][bj][m][n], 0, 0, 0); __builtin_amdgcn_s_setprio(0); } while (0)
#define PG8_WAIT_V(n) asm volatile("s_waitcnt vmcnt(" #n ")" ::: "memory")
#define PG8_WAIT_L(n) asm volatile("s_waitcnt lgkmcnt(" #n ")" ::: "memory")
#define PG8_BAR __builtin_amdgcn_s_barrier()
#define PG8_SCHED __builtin_amdgcn_sched_barrier(0)
    Unit cur, nxt; int ui = 0;
    if (!S.next(0, cur)) return;
    f32x4 acc[2][2][4][2];
#pragma unroll
    for (int a = 0; a < 2; ++a)
#pragma unroll
        for (int b = 0; b < 2; ++b)
#pragma unroll
            for (int m = 0; m < 4; ++m)
#pragma unroll
                for (int n = 0; n < 2; ++n) acc[a][b][m][n] = (f32x4){0.f, 0.f, 0.f, 0.f};
    bf16x8 At[4][2], B0[2][2], B1[2][2];
    const char* cA = (const char*)g.A + (size_t)cur.pm * tstepA; const char* cB = (const char*)g.Bt + (size_t)cur.pn * tstepB;
    if (Epi::SP2) {
        PG8_STAGE(PG8_SB(0, 0), cB, voffB); PG8_STAGE(PG8_SB(0, 1), cB + hstepB, voffB); PG8_STAGE(PG8_SA(0, 0), cA, voffA); PG8_STAGE(PG8_SA(0, 1), cA + hstepA, voffA);
        if (wr == 1) PG8_BAR;
        PG8_WAIT_V(2); PG8_BAR;
    } else {
        PG8_STAGE(PG8_SB(0, 0), cB, voffB); PG8_STAGE(PG8_SA(0, 0), cA, voffA); PG8_STAGE(PG8_SB(0, 1), cB + hstepB, voffB); PG8_STAGE(PG8_SA(0, 1), cA + hstepA, voffA);
        if (wr == 1) PG8_BAR;
        PG8_WAIT_V(4); PG8_BAR;
    }
    PG8_STAGE(PG8_SB(1, 0), cB + kstep, voffB); PG8_STAGE(PG8_SA(1, 0), cA + kstep, voffA); PG8_STAGE(PG8_SB(1, 1), cB + hstepB + kstep, voffB);
    PG8_WAIT_V(6); PG8_BAR;
    for (;;) {
        const bool has_next = S.next(ui + 1, nxt);
        const char* nA = has_next ? (const char*)g.A + (size_t)nxt.pm * tstepA : cA; const char* nB = has_next ? (const char*)g.Bt + (size_t)nxt.pn * tstepB : cB;
        for (int t = 0; t < nt; t += 2) {
            const bool last = (t == nt - 2);
            const char* a1 = cA + (size_t)(t + 1) * kstep;
            const char* a2 = last ? nA : cA + (size_t)(t + 2) * kstep; const char* b2 = last ? nB : cB + (size_t)(t + 2) * kstep;
            const char* a3 = a2 + kstep; const char* b3 = b2 + kstep;
            if (Epi::SP2) {
            PG8_LDB(B0, 0, 0); PG8_LDB(B1, 0, 1); PG8_SCHED; PG8_LDA(At, 0, 0); PG8_STAGE(PG8_SA(1, 1), a1 + hstepA, voffA);
            PG8_WAIT_V(8); PG8_WAIT_L(0); PG8_BAR; PG8_MMA(0, 0, At, B0); PG8_MMA(0, 1, At, B1); PG8_BAR; PG8_SCHED;
            PG8_LDA(At, 0, 1); PG8_STAGE(PG8_SB(0, 0), b2, voffB); PG8_STAGE(PG8_SB(0, 1), b2 + hstepB, voffB); PG8_STAGE(PG8_SA(0, 0), a2, voffA);
            PG8_WAIT_V(8); PG8_WAIT_L(0); PG8_BAR; PG8_MMA(1, 0, At, B0); PG8_MMA(1, 1, At, B1); PG8_BAR; PG8_SCHED;
            PG8_LDB(B0, 1, 0); PG8_LDB(B1, 1, 1); PG8_SCHED; PG8_LDA(At, 1, 0); PG8_STAGE(PG8_SA(0, 1), a2 + hstepA, voffA);
            PG8_WAIT_V(8); PG8_WAIT_L(0); PG8_BAR; PG8_MMA(0, 0, At, B0); PG8_MMA(0, 1, At, B1); PG8_BAR; PG8_SCHED;
            PG8_LDA(At, 1, 1); PG8_STAGE(PG8_SB(1, 0), b3, voffB); PG8_STAGE(PG8_SB(1, 1), b3 + hstepB, voffB); PG8_STAGE(PG8_SA(1, 0), a3, voffA);
            PG8_WAIT_V(8); PG8_WAIT_L(0); PG8_BAR; PG8_MMA(1, 0, At, B0); PG8_MMA(1, 1, At, B1); PG8_BAR; PG8_SCHED;
            } else {
            PG8_LDB(B0, 0, 0); PG8_SCHED; PG8_LDA(At, 0, 0); PG8_STAGE(PG8_SA(1, 1), a1 + hstepA, voffA);
            PG8_WAIT_L(8); PG8_BAR; PG8_WAIT_L(0); PG8_MMA(0, 0, At, B0); PG8_BAR; PG8_SCHED;
            PG8_LDB(B1, 0, 1); PG8_STAGE(PG8_SB(0, 0), b2, voffB);
            PG8_BAR; PG8_WAIT_L(0); PG8_MMA(0, 1, At, B1); PG8_BAR;
            PG8_LDA(At, 0, 1); PG8_STAGE(PG8_SA(0, 0), a2, voffA);
            PG8_BAR; PG8_WAIT_L(0); PG8_MMA(1, 0, At, B0); PG8_BAR; PG8_SCHED;
            PG8_STAGE(PG8_SB(0, 1), b2 + hstepB, voffB);
            PG8_WAIT_V(6); PG8_BAR; PG8_MMA(1, 1, At, B1); PG8_BAR;
            PG8_LDB(B0, 1, 0); PG8_SCHED; PG8_LDA(At, 1, 0); PG8_STAGE(PG8_SA(0, 1), a2 + hstepA, voffA);
            PG8_WAIT_L(8); PG8_BAR; PG8_WAIT_L(0); PG8_MMA(0, 0, At, B0); PG8_BAR; PG8_SCHED;
            PG8_LDB(B1, 1, 1); PG8_STAGE(PG8_SB(1, 0), b3, voffB);
            PG8_BAR; PG8_WAIT_L(0); PG8_MMA(0, 1, At, B1); PG8_BAR;
            PG8_LDA(At, 1, 1); PG8_STAGE(PG8_SA(1, 0), a3, voffA);
            PG8_BAR; PG8_WAIT_L(0); PG8_MMA(1, 0, At, B0); PG8_BAR; PG8_SCHED;
            PG8_STAGE(PG8_SB(1, 1), b3 + hstepB, voffB);
            PG8_WAIT_V(6); PG8_BAR; PG8_MMA(1, 1, At, B1); PG8_BAR;
            }
        }
        if (Epi::ALIGN) { if (wr == 0) PG8_BAR; }
        E(acc, cur, wr, wc, fr, fq);
        if (!has_next) break;
#pragma unroll
        for (int a = 0; a < 2; ++a)
#pragma unroll
            for (int b = 0; b < 2; ++b)
#pragma unroll
                for (int m = 0; m < 4; ++m)
#pragma unroll
                    for (int n = 0; n < 2; ++n) acc[a][b][m][n] = (f32x4){0.f, 0.f, 0.f, 0.f};
        cur = nxt; cA = nA; cB = nB; ++ui;
        if (Epi::ALIGN) { if (wr == 1) PG8_BAR; }
    }
    PG8_WAIT_V(0);
    if (!Epi::ALIGN) { if (wr == 0) PG8_BAR; }
    PG8_BAR;
#undef PG8_SA
#undef PG8_SB
#undef PG8_STAGE
#undef PG8_LDA
#undef PG8_LDB
#undef PG8_MMA
#undef PG8_WAIT_V
#undef PG8_WAIT_L
#undef PG8_BAR
#undef PG8_SCHED
}
}

__device__ __forceinline__ float row_rstd(const float* part, int row, int fq) {
    const f32x4 a = *(const f32x4*)(part + (size_t)row * 32 + fq * 8), b = *(const f32x4*)(part + (size_t)row * 32 + fq * 8 + 4);
    float s = ((a[0] + a[1]) + (a[2] + a[3])) + ((b[0] + b[1]) + (b[2] + b[3]));
    s += __shfl_xor(s, 16); s += __shfl_xor(s, 32);
    return __builtin_amdgcn_rsqf(s * (1.0f / 2048.0f) + EPSF);
}
enum { EP_GMLP_IN = 0, EP_RESID, EP_FFN_IN, EP_PLE, EP_PROJ, EP_KV, EP_QG, EP_C1, EP_C2 };
struct EpiP {
    const float* ss_in; float* ss_out; const float* xres; float* xout; bf16_t* xb;
    bf16_t* o0; bf16_t* o1; float* f0; const bf16_t* aux; const float* bias; float* ssv;
};
__device__ __forceinline__ void st_bf16x4(bf16_t* p, f32x4 v) { u32x2 w; w.x = cvt_pk_bf16(v[0], v[1]); w.y = cvt_pk_bf16(v[2], v[3]); *(u32x2*)p = w; }
__device__ __forceinline__ void st_bf16x8(bf16_t* p, f32x4 a, f32x4 b) { u32x4 w; w.x = cvt_pk_bf16(a[0], a[1]); w.y = cvt_pk_bf16(a[2], a[3]); w.z = cvt_pk_bf16(b[0], b[1]); w.w = cvt_pk_bf16(b[2], b[3]); *(u32x4*)p = w; }
__device__ __forceinline__ void ld_bf16x8(const bf16_t* p, f32x4& a, f32x4& b) { const u32x4 w = *(const u32x4*)p;
    a[0] = bflo(w.x); a[1] = bfhi(w.x); a[2] = bflo(w.y); a[3] = bfhi(w.y); b[0] = bflo(w.z); b[1] = bfhi(w.z); b[2] = bflo(w.w); b[3] = bfhi(w.w); }

template <int MODE> struct Epi {
    EpiP p;
    static constexpr bool ALIGN = (MODE == EP_FFN_IN || MODE == EP_GMLP_IN);
    static constexpr bool SP2 = (MODE == EP_FFN_IN || MODE == EP_RESID || MODE == EP_GMLP_IN || MODE == EP_PLE || MODE == EP_QG || MODE == EP_KV);
    static constexpr bool F16 = (MODE == EP_GMLP_IN || MODE == EP_FFN_IN || MODE == EP_PLE || MODE == EP_KV || MODE == EP_QG);
    __device__ __forceinline__ void operator()(const f32x4 (&acc)[2][2][4][2], const pg8::Unit& u, int wr, int wc, int fr, int fq) const {
        const int row0 = u.pm * 256 + wr * 64 + fr;
        const int cin = wc * 32 + 8 * fq;
        constexpr bool NEEDR = F16;
        float rr[2][4];
        if (NEEDR) {
#pragma unroll
            for (int ai = 0; ai < 2; ++ai) {
                f32x4 pa[4], pb[4];
#pragma unroll
                for (int m = 0; m < 4; ++m) { const float* pp = p.ss_in + (size_t)(row0 + ai * 128 + m * 16) * 32 + fq * 8; pa[m] = *(const f32x4*)pp; pb[m] = *(const f32x4*)(pp + 4); }
                __builtin_amdgcn_sched_barrier(0);
#pragma unroll
                for (int m = 0; m < 4; ++m) { const f32x4 a = pa[m], b = pb[m]; float sm = ((a[0] + a[1]) + (a[2] + a[3])) + ((b[0] + b[1]) + (b[2] + b[3]));
                    sm += __shfl_xor(sm, 16); sm += __shfl_xor(sm, 32); rr[ai][m] = __builtin_amdgcn_rsqf(sm * (1.0f / 2048.0f) + EPSF); }
                __builtin_amdgcn_sched_barrier(0);
            }
        }
        if (MODE == EP_RESID || MODE == EP_PLE) {
            constexpr int RB = (MODE == EP_PLE) ? 1 : 4;
#pragma unroll
            for (int rb0 = 0; rb0 < 8; rb0 += RB) {
                u32x4 xr[RB][2], pr[RB][2];
#pragma unroll
                for (int q = 0; q < RB; ++q)
#pragma unroll
                    for (int bj = 0; bj < 2; ++bj) { const int ai = (rb0 + q) >> 2, m = (rb0 + q) & 3; const size_t o = (size_t)(row0 + ai * 128 + m * 16) * 2048 + u.pn * 256 + cin + bj * 128;
                        xr[q][bj] = *(const u32x4*)(p.o1 + o); if (MODE == EP_PLE) pr[q][bj] = *(const u32x4*)(p.aux + o); }
                __builtin_amdgcn_sched_barrier(0);
#pragma unroll
                for (int q = 0; q < RB; ++q) {
                    const int ai = (rb0 + q) >> 2, m = (rb0 + q) & 3;
                    const int row = row0 + ai * 128 + m * 16; const size_t off = (size_t)row * 2048 + u.pn * 256 + cin; const float r = NEEDR ? rr[ai][m] : 1.0f;
                    float sq = 0.f;
#pragma unroll
                    for (int bj = 0; bj < 2; ++bj) { const size_t o = off + bj * 128; const u32x4 w = xr[q][bj];
                        f32x4 x0, x1, a0 = acc[ai][bj][m][0], a1 = acc[ai][bj][m][1];
                        x0[0] = h2lo(w.x); x0[1] = h2hi(w.x); x0[2] = h2lo(w.y); x0[3] = h2hi(w.y); x1[0] = h2lo(w.z); x1[1] = h2hi(w.z); x1[2] = h2lo(w.w); x1[3] = h2hi(w.w);
                        if (MODE == EP_PLE) { const u32x4 qq = pr[q][bj];
                            a0[0] = bflo(qq.x) * sigm(a0[0] * r); a0[1] = bfhi(qq.x) * sigm(a0[1] * r); a0[2] = bflo(qq.y) * sigm(a0[2] * r); a0[3] = bfhi(qq.y) * sigm(a0[3] * r);
                            a1[0] = bflo(qq.z) * sigm(a1[0] * r); a1[1] = bfhi(qq.z) * sigm(a1[1] * r); a1[2] = bflo(qq.w) * sigm(a1[2] * r); a1[3] = bfhi(qq.w) * sigm(a1[3] * r); }
                        x0 = x0 + a0; x1 = x1 + a1;
                        if (p.xout) { *(f32x4*)(p.xout + o) = x0; *(f32x4*)(p.xout + o + 4) = x1; }
                        if (p.xb) { u32x4 wv; wv.x = cvt_pk_f16(x0[0], x0[1]); wv.y = cvt_pk_f16(x0[2], x0[3]); wv.z = cvt_pk_f16(x1[0], x1[1]); wv.w = cvt_pk_f16(x1[2], x1[3]); *(u32x4*)(p.xb + o) = wv; }
                        sq += ((x0[0] * x0[0] + x0[1] * x0[1]) + (x0[2] * x0[2] + x0[3] * x0[3])) + ((x1[0] * x1[0] + x1[1] * x1[1]) + (x1[2] * x1[2] + x1[3] * x1[3])); }
                    if (p.ss_out) { sq += __shfl_xor(sq, 16); sq += __shfl_xor(sq, 32); if (fq == 0) p.ss_out[(size_t)row * 32 + u.pn * 4 + wc] = sq; }
                }
                __builtin_amdgcn_sched_barrier(0);
            }
            return;
        }
        f32x4 cb[2][2];
        if (MODE == EP_C1) {
#pragma unroll
            for (int bj = 0; bj < 2; ++bj) { cb[bj][0] = *(const f32x4*)(p.bias + bj * 128 + cin); cb[bj][1] = *(const f32x4*)(p.bias + bj * 128 + cin + 4); }
        }
#pragma unroll
        for (int ai = 0; ai < 2; ++ai)
#pragma unroll
            for (int m = 0; m < 4; ++m) {
                const int row = row0 + ai * 128 + m * 16;
                const float r = NEEDR ? rr[ai][m] : 1.0f;
                if (MODE == EP_GMLP_IN) {
                    const bool isv = u.pn >= 8; bf16_t* dst = (isv ? p.o1 : p.o0) + (size_t)row * 2048 + (u.pn & 7) * 256 + cin;
                    float sq = 0.f;
#pragma unroll
                    for (int bj = 0; bj < 2; ++bj) { f32x4 v0 = acc[ai][bj][m][0] * r, v1 = acc[ai][bj][m][1] * r;
#pragma unroll
                        for (int j = 0; j < 4; ++j) { v0[j] = gelu_t(v0[j]); v1[j] = gelu_t(v1[j]); sq += v0[j] * v0[j] + v1[j] * v1[j]; }
                        st_bf16x8(dst + bj * 128, v0, v1); }
                    if (isv) { sq += __shfl_xor(sq, 16); sq += __shfl_xor(sq, 32); if (fq == 0) p.ssv[(size_t)row * 32 + (u.pn - 8) * 4 + wc] = sq; }
                } else if (MODE == EP_FFN_IN) {
                    bf16_t* dst = p.o0 + (size_t)row * FFD + u.pn * 128 + cin;
                    f32x4 h0, h1;
#pragma unroll
                    for (int j = 0; j < 4; ++j) { const float g0 = acc[ai][0][m][0][j] * r, g1 = acc[ai][0][m][1][j] * r;
                        h0[j] = g0 * sigm(g0) * (acc[ai][1][m][0][j] * r); h1[j] = g1 * sigm(g1) * (acc[ai][1][m][1][j] * r); }
                    st_bf16x8(dst, h0, h1);
                } else if (MODE == EP_PROJ) {
                    bf16_t* dst = p.o0 + (size_t)row * 2048 + u.pn * 256 + cin;
#pragma unroll
                    for (int bj = 0; bj < 2; ++bj) st_bf16x8(dst + bj * 128, acc[ai][bj][m][0], acc[ai][bj][m][1]);
                } else if (MODE == EP_KV) {
                    const int br = u.pn;
#pragma unroll
                    for (int bj = 0; bj < 2; ++bj) { const f32x4 v0 = acc[ai][bj][m][0] * r, v1 = acc[ai][bj][m][1] * r; const size_t o = ((size_t)bj * SEQ + row) * 128 + cin;
                        if (br == 0) st_bf16x8(p.o0 + o, v0, v1);
                        else if (br == 1) st_bf16x8(p.o1 + o, v0, v1);
                        else { float* d = p.f0 + (size_t)(br - 2) * 2 * SEQ * 128 + o; *(f32x4*)d = v0; *(f32x4*)(d + 4) = v1; } }
                } else if (MODE == EP_QG) {
                    if (u.pn < 8) {
                        bf16_t* dst = p.o0 + (size_t)row * 2048 + u.pn * 256 + cin;
#pragma unroll
                        for (int bj = 0; bj < 2; ++bj) st_bf16x8(dst + bj * 128, acc[ai][bj][m][0] * r, acc[ai][bj][m][1] * r);
                    } else if (cin < 48) {
#pragma unroll
                        for (int n = 0; n < 2; ++n) { f32x4 v = acc[ai][0][m][n] * r;
#pragma unroll
                            for (int j = 0; j < 4; ++j) v[j] = sigm(v[j]);
                            *(f32x4*)(p.f0 + (size_t)row * 48 + cin + 4 * n) = v; }
                    }
                } else if (MODE == EP_C1) {
#pragma unroll
                    for (int bj = 0; bj < 2; ++bj) { const int c = bj * 128 + cin; f32x4 v0 = acc[ai][bj][m][0] + cb[bj][0], v1 = acc[ai][bj][m][1] + cb[bj][1];
#pragma unroll
                        for (int j = 0; j < 4; ++j) { v0[j] = gelu_t(v0[j]); v1[j] = gelu_t(v1[j]); }
                        st_bf16x8(p.o0 + (size_t)row * 256 + c, v0, v1); }
                } else if (MODE == EP_C2) {
                    float* d = p.f0 + (size_t)row * 128 + cin; *(f32x4*)d = acc[ai][0][m][0]; *(f32x4*)(d + 4) = acc[ai][0][m][1];
                }
            }
    }
};

struct Params {
    const float *x, *p, *norm_mix, *norm_ffn, *norm_ple, *a_w_in, *a_norm_v, *a_w_s, *a_b_s, *a_w_out, *kv_norm, *kv_w, *k_norm,
        *cmp_pe_k, *cmp_pe_v, *cmp_wk1, *cmp_wk2, *cmp_wv1, *cmp_wv2, *b_w_in, *b_q_norm, *b_w_out, *rel_bias, *ffn_w_in, *ffn_w_out, *ple_w, *ple_gate;
    float* out; unsigned char* ws;
};

__device__ __forceinline__ void transpose_item(const float* __restrict__ W, int K, int Nsrc, int Npad, bf16_t* WT, const float* gain, int mode, LAS float* scr, int item, int lane) {
    const int nblk = Npad / 64, kb = item / nblk, nb = item % nblk, k0 = 64 * kb, n0 = 64 * nb;
    const int r4 = lane >> 4, c4 = (lane & 15) * 4; const bool ok = n0 + c4 < Nsrc;
#pragma unroll 4
    for (int i = 0; i < 16; ++i) { const int kk = 4 * i + r4; f32x4 v = ok ? *(const f32x4*)(W + (size_t)(k0 + kk) * Nsrc + n0 + c4) : (f32x4){0.f, 0.f, 0.f, 0.f};
        if (gain) v = v * gain[k0 + kk];
        LAS float* d = scr + kk * 65 + c4; d[0] = v[0]; d[1] = v[1]; d[2] = v[2]; d[3] = v[3]; }
    LDS_WAIT();
    int drow0 = n0;
    if (mode & 1) { const int ty = n0 >= FFD ? 1 : 0, j0 = n0 - ty * FFD; drow0 = 256 * (j0 >> 7) + 128 * ty + (j0 & 127); }
    const int c = lane & 7;
#pragma unroll
    for (int j = 0; j < 8; ++j) { const int n = (lane >> 3) + 8 * j; const LAS float* sp = scr + (8 * c) * 65 + n;
        u32x4 o;
        if (mode & 2) {
            const unsigned b0 = cvt_pk_bf16(sp[0 * 65], sp[1 * 65]), b1 = cvt_pk_bf16(sp[2 * 65], sp[3 * 65]), b2 = cvt_pk_bf16(sp[4 * 65], sp[5 * 65]), b3 = cvt_pk_bf16(sp[6 * 65], sp[7 * 65]);
            o.x = cvt_pk_f16(bflo(b0), bfhi(b0)); o.y = cvt_pk_f16(bflo(b1), bfhi(b1)); o.z = cvt_pk_f16(bflo(b2), bfhi(b2)); o.w = cvt_pk_f16(bflo(b3), bfhi(b3)); }
        else { o.x = cvt_pk_bf16(sp[0 * 65], sp[1 * 65]); o.y = cvt_pk_bf16(sp[2 * 65], sp[3 * 65]); o.z = cvt_pk_bf16(sp[4 * 65], sp[5 * 65]); o.w = cvt_pk_bf16(sp[6 * 65], sp[7 * 65]); }
        *(u32x4*)(WT + (size_t)(drow0 + n) * K + k0 + 8 * c) = o; }
    LDS_WAIT();
}

__device__ __forceinline__ void convert_set(const Params& P, LAS unsigned char* lds, int set, int widx, int nw, int lane, int wave) {
    unsigned char* ws = P.ws;
    LAS float* scr = (LAS float*)lds + wave * (64 * 65);
    constexpr int I_AIN = (2048 / 64) * (4096 / 64), I_SQ = (2048 / 64) * (2048 / 64), I_FIN = (2048 / 64) * (11264 / 64), I_FOUT = (5632 / 64) * (2048 / 64),
                  I_PW = (256 / 64) * (2048 / 64), I_KV = (2048 / 64) * (1536 / 64), I_BIN = (2048 / 64) * (2304 / 64), I_C1 = (4096 / 64) * (256 / 64), I_C2 = (256 / 64) * (128 / 64);
    const int total = set == 0 ? I_AIN + I_SQ + 3 * I_FIN + 4 * I_PW
                    : set == 1 ? I_FOUT + I_SQ + I_AIN + I_SQ
                    : set == 2 ? I_FOUT + I_SQ + I_KV + I_BIN + I_SQ + 2 * I_C1 + 2 * I_C2
                    : set == 3 ? I_FOUT + I_SQ + I_BIN + I_SQ
                    : set == 4 ? I_FOUT + I_SQ
                    :            I_FIN;
    for (int item = widx; item < total; item += nw) {
        int r = item;
#define TJ(SET, CNT, W, K, NS, NP, WT, GAIN, MODE) if (set == (SET)) { if (r < (CNT)) { transpose_item((W), (K), (NS), (NP), (bf16_t*)(WT), (GAIN), (MODE), scr, r, lane); continue; } r -= (CNT); }
        TJ(0, I_AIN, P.a_w_in, 2048, 4096, 4096, ws + O_WAIN, P.norm_mix, 2)
        TJ(0, I_SQ, P.a_w_out, 2048, 2048, 2048, ws + O_WAOUT, nullptr, 0)
        TJ(0, I_FIN, P.ffn_w_in, 2048, 11264, 11264, ws + O_WFIN, P.norm_ffn, 3)
        TJ(0, I_FIN, P.ffn_w_in + 1 * 2048ull * 11264, 2048, 11264, 11264, ws + O_WFIN + 1 * 11264ull * 2048 * 2, P.norm_ffn + 2048, 3)
        TJ(0, I_FIN, P.ffn_w_in + 2 * 2048ull * 11264, 2048, 11264, 11264, ws + O_WFIN + 2 * 11264ull * 2048 * 2, P.norm_ffn + 4096, 3)
        TJ(5, I_FIN, P.ffn_w_in + 3 * 2048ull * 11264, 2048, 11264, 11264, ws + O_WFIN + 3 * 11264ull * 2048 * 2, P.norm_ffn + 6144, 3)
        TJ(0, I_PW, P.ple_w, 256, 2048, 2048, ws + O_WPW, nullptr, 0)
        TJ(0, I_PW, P.ple_w + 1 * 256ull * 2048, 256, 2048, 2048, ws + O_WPW + 1 * 2048ull * 256 * 2, nullptr, 0)
        TJ(0, I_PW, P.ple_w + 2 * 256ull * 2048, 256, 2048, 2048, ws + O_WPW + 2 * 2048ull * 256 * 2, nullptr, 0)
        TJ(0, I_PW, P.ple_w + 3 * 256ull * 2048, 256, 2048, 2048, ws + O_WPW + 3 * 2048ull * 256 * 2, nullptr, 0)
        TJ(1, I_FOUT, P.ffn_w_out, 5632, 2048, 2048, ws + O_WFOUT, nullptr, 0)
        TJ(1, I_SQ, P.ple_gate, 2048, 2048, 2048, ws + O_WPG, P.norm_ple, 2)
        TJ(1, I_AIN, P.a_w_in + 2048ull * 4096, 2048, 4096, 4096, ws + O_WAIN + 4096ull * 2048 * 2, P.norm_mix + 2048, 2)
        TJ(1, I_SQ, P.a_w_out + 2048ull * 2048, 2048, 2048, 2048, ws + O_WAOUT + 2048ull * 2048 * 2, nullptr, 0)
        TJ(2, I_FOUT, P.ffn_w_out + 1 * 5632ull * 2048, 5632, 2048, 2048, ws + O_WFOUT + 1 * 2048ull * 5632 * 2, nullptr, 0)
        TJ(2, I_SQ, P.ple_gate + 1 * 2048ull * 2048, 2048, 2048, 2048, ws + O_WPG + 1 * 2048ull * 2048 * 2, P.norm_ple + 2048, 2)
        TJ(2, I_KV, P.kv_w, 2048, 1536, 1536, ws + O_WKV, P.kv_norm, 2)
        TJ(2, I_BIN, P.b_w_in, 2048, 2096, 2304, ws + O_WBIN, P.norm_mix + 4096, 2)
        TJ(2, I_SQ, P.b_w_out, 2048, 2048, 2048, ws + O_WBOUT, nullptr, 0)
        TJ(2, I_C1, P.cmp_wk1, 4096, 256, 256, ws + O_WC1, nullptr, 0)
        TJ(2, I_C1, P.cmp_wv1, 4096, 256, 256, ws + O_WC1 + 256ull * 4096 * 2, nullptr, 0)
        TJ(2, I_C2, P.cmp_wk2, 256, 128, 128, ws + O_WC2, nullptr, 0)
        TJ(2, I_C2, P.cmp_wv2, 256, 128, 128, ws + O_WC2 + 256ull * 256 * 2, nullptr, 0)
        TJ(3, I_FOUT, P.ffn_w_out + 2 * 5632ull * 2048, 5632, 2048, 2048, ws + O_WFOUT + 2 * 2048ull * 5632 * 2, nullptr, 0)
        TJ(3, I_SQ, P.ple_gate + 2 * 2048ull * 2048, 2048, 2048, 2048, ws + O_WPG + 2 * 2048ull * 2048 * 2, P.norm_ple + 4096, 2)
        TJ(3, I_BIN, P.b_w_in + 2048ull * 2096, 2048, 2096, 2304, ws + O_WBIN + 2304ull * 2048 * 2, P.norm_mix + 6144, 2)
        TJ(3, I_SQ, P.b_w_out + 2048ull * 2048, 2048, 2048, 2048, ws + O_WBOUT + 2048ull * 2048 * 2, nullptr, 0)
        TJ(4, I_FOUT, P.ffn_w_out + 3 * 5632ull * 2048, 5632, 2048, 2048, ws + O_WFOUT + 3 * 2048ull * 5632 * 2, nullptr, 0)
        TJ(4, I_SQ, P.ple_gate + 3 * 2048ull * 2048, 2048, 2048, 2048, ws + O_WPG + 3 * 2048ull * 2048 * 2, P.norm_ple + 6144, 2)
#undef TJ
    }
}

__device__ __forceinline__ void phase_prologue(const Params& P, LAS unsigned char* lds) {
    unsigned char* ws = P.ws;
    const int tid = otid(), lane = tid & 63, wave = tid >> 6;
    const int gwave = blockIdx.x * 8 + wave, nwaves = gridDim.x * 8;
    const int gtid = blockIdx.x * NTHREADS + tid, nthr = gridDim.x * NTHREADS;
    convert_set(P, lds, 0, gwave, nwaves, lane, wave);
    if (gridDim.x != 256) { for (int st = 1; st <= 5; ++st) convert_set(P, lds, st, gwave, nwaves, lane, wave); }
    {
        bf16_t* xb = (bf16_t*)(ws + O_XB); float* ss = (float*)(ws + O_SS);
        for (int row = gwave; row < SEQ; row += nwaves) {
            const f32x4* xr = (const f32x4*)(P.x + (size_t)row * DM) + lane; float s = 0.f;
#pragma unroll
            for (int j = 0; j < 8; ++j) { const f32x4 v = xr[64 * j]; s += (v[0] * v[0] + v[1] * v[1]) + (v[2] * v[2] + v[3] * v[3]);
                u32x2 wv; wv.x = cvt_pk_f16(v[0], v[1]); wv.y = cvt_pk_f16(v[2], v[3]); *(u32x2*)(xb + (size_t)row * DM + (64 * j + lane) * 4) = wv; }
            s = wave_sum(s); if (lane < 32) ss[(size_t)row * 32 + lane] = lane == 0 ? s : 0.f;
        }
    }
    { const f32x4* src = (const f32x4*)P.p; bf16_t* dst = (bf16_t*)(ws + O_PB); for (int i = gtid; i < 4 * SEQ * PLED / 4; i += nthr) st_bf16x4(dst + (size_t)i * 4, src[i]); }
    { const f32x4* src = (const f32x4*)P.a_w_s; bf16_t* dst = (bf16_t*)(ws + O_WSB);
      for (int i = gtid; i < 2 * 16 * 128 * 128 / 4; i += nthr) { f32x4 v = src[i]; const int s0 = (i * 4) & 127, t = ((i * 4) >> 7) & 127;
#pragma unroll
          for (int j = 0; j < 4; ++j) if (s0 + j > t) v[j] = 0.f;
          st_bf16x4(dst + (size_t)i * 4, v); } }
    __syncthreads();
    if (blockIdx.x < 16) {
        const int mtx = blockIdx.x >> 3, n = (blockIdx.x & 7) * 32 + (tid & 31), ks = tid >> 5;
        const float* pe = mtx ? P.cmp_pe_v : P.cmp_pe_k; const float* w1 = mtx ? P.cmp_wv1 : P.cmp_wk1;
        float s = 0.f;
        for (int i = 0; i < 256; ++i) { const int k = ks + 16 * i; s += pe[k] * w1[(size_t)k * 256 + n]; }
        LAS float* red = (LAS float*)lds;
        red[ks * 32 + (tid & 31)] = s; LDS_WAIT(); __syncthreads();
        if (tid < 32) { float t = 0.f; for (int i = 0; i < 16; ++i) t += red[i * 32 + tid]; ((float*)(ws + O_CB))[mtx * 256 + (blockIdx.x & 7) * 32 + tid] = t; }
        __syncthreads();
    }
}

__device__ __forceinline__ void phase_sgu(const Params& P, LAS unsigned char* lds, int layer) {
    unsigned char* ws = P.ws;
    const int tid = otid(), lane = tid & 63, wave = __builtin_amdgcn_readfirstlane(tid >> 6), fr = lane & 15, fq = lane >> 4;
    const bf16_t* ZU = (const bf16_t*)(ws + O_ZU); const bf16_t* ZV = (const bf16_t*)(ws + O_ZV); bf16_t* Y = (bf16_t*)(ws + O_Y);
    const float* ssv = (const float*)(ws + O_SSV) + (size_t)layer * SEQ * 32; const float* nv = P.a_norm_v + layer * 2048; const float* bs = P.a_b_s + layer * 16 * 128;
    constexpr int LDR = 136;
    LAS bf16_t* As = (LAS bf16_t*)lds; LAS bf16_t* Bs = As + 128 * LDR; LAS float* rsl = (LAS float*)(Bs + 128 * LDR);
    for (int unit = blockIdx.x; unit < 1024; unit += gridDim.x) {
        const int g = unit & 15, c = unit >> 4;
        const bf16_t* Wsg = (const bf16_t*)(ws + O_WSB) + ((size_t)(layer * 16 + g)) * 128 * 128;
        __syncthreads();
        if (tid < 128) {
            const int row = c * 128 + tid; float ssum = 0.f;
#pragma unroll
            for (int e = 0; e < 8; ++e) { const f32x4 pv = *(const f32x4*)(ssv + (size_t)row * 32 + 4 * e); ssum += (pv[0] + pv[1]) + (pv[2] + pv[3]); }
            rsl[tid] = __builtin_amdgcn_rsqf(ssum * (1.0f / 2048.0f) + EPSF);
        }
        LDS_WAIT(); __syncthreads();
#pragma unroll
        for (int ps = 0; ps < 4; ++ps) { const int idx = tid + 512 * ps, r = idx >> 4, c16 = idx & 15;
            *(LAS u32x4*)(As + r * LDR + c16 * 8) = *(const u32x4*)(Wsg + r * 128 + c16 * 8);
            const int row = c * 128 + r; const u32x4 vv = *(const u32x4*)(ZV + (size_t)row * 2048 + g * 128 + c16 * 8);
            const float rs = rsl[r];
            const f32x4 n0 = *(const f32x4*)(nv + g * 128 + c16 * 8), n1 = *(const f32x4*)(nv + g * 128 + c16 * 8 + 4);
            const unsigned w4[4] = {vv.x, vv.y, vv.z, vv.w};
#pragma unroll
            for (int q = 0; q < 4; ++q) { const float a = bflo(w4[q]) * rs * (q < 2 ? n0[2 * q] : n1[2 * q - 4]), b = bfhi(w4[q]) * rs * (q < 2 ? n0[2 * q + 1] : n1[2 * q - 3]);
                const unsigned pk = cvt_pk_bf16(a, b);
                Bs[(c16 * 8 + 2 * q) * LDR + r] = (bf16_t)(pk & 0xffffu); Bs[(c16 * 8 + 2 * q + 1) * LDR + r] = (bf16_t)(pk >> 16); } }
        LDS_WAIT(); __syncthreads();
        f32x4 acc[8];
#pragma unroll
        for (int n = 0; n < 8; ++n) acc[n] = (f32x4){0.f, 0.f, 0.f, 0.f};
        const int nkk = (wave >> 1) + 1;
        for (int kk = 0; kk < nkk; ++kk) {
            const bf16x8 af = *(const LAS bf16x8*)(As + (16 * wave + fr) * LDR + 32 * kk + 8 * fq);
#pragma unroll
            for (int n = 0; n < 8; ++n) { const bf16x8 bfg = *(const LAS bf16x8*)(Bs + (16 * n + fr) * LDR + 32 * kk + 8 * fq);
                acc[n] = __builtin_amdgcn_mfma_f32_16x16x32_bf16(bfg, af, acc[n], 0, 0, 0); }
        }
        const int t = 16 * wave + fr, row = c * 128 + t; const float b = bs[g * 128 + t];
#pragma unroll
        for (int n = 0; n < 8; ++n) { const size_t o = (size_t)row * 2048 + g * 128 + 16 * n + 4 * fq; const u32x2 uw = *(const u32x2*)(ZU + o);
            f32x4 v; v[0] = bflo(uw.x) * (acc[n][0] + b); v[1] = bfhi(uw.x) * (acc[n][1] + b); v[2] = bflo(uw.y) * (acc[n][2] + b); v[3] = bfhi(uw.y) * (acc[n][3] + b);
            st_bf16x4(Y + o, v); }
    }
    __syncthreads();
}

__device__ __forceinline__ int vswz(int kidx, int d) {
    const int kt = kidx >> 4, ks = kt >> 1, half = kt & 1, fq = (kidx & 15) >> 2, i = kidx & 3, dt = d >> 4, fr = d & 15;
    return ((dt * 2 + ks) * 64 + fq * 16 + fr) * 8 + half * 4 + i;
}
__device__ __forceinline__ void phase_kvprep(const Params& P) {
    unsigned char* ws = P.ws;
    const int tid = otid(), lane = tid & 63, gwave = blockIdx.x * 8 + (tid >> 6), nwaves = gridDim.x * 8;
    const float* tmp = (const float*)(ws + O_KVTMP);
    for (int it = gwave; it < 2 * 2 * SEQ; it += nwaves) {
        const int b = it / (2 * SEQ), rem = it % (2 * SEQ);
        const float* src = tmp + ((size_t)(b * 2) * 2 * SEQ + rem) * 128; const f32x2 v = *(const f32x2*)(src + 2 * lane);
        const float rs = __builtin_amdgcn_rsqf(wave_sum(v[0] * v[0] + v[1] * v[1]) * (1.0f / 128.0f) + EPSF);
        const float* kn = P.k_norm + (b + 1) * 128;
        bf16_t* dst = (bf16_t*)(ws + (b ? O_KW : O_KS)) + (size_t)rem * 128;
        *(unsigned*)(dst + 2 * lane) = cvt_pk_bf16(v[0] * rs * kn[2 * lane], v[1] * rs * kn[2 * lane + 1]);
    }
    for (int it = gwave; it < 2 * 2 * (SEQ / 4); it += nwaves) {
        const int b = it / (2 * (SEQ / 4)), rem = it % (2 * (SEQ / 4)), g = rem / (SEQ / 4), p4 = rem % (SEQ / 4), pos = p4 * 4;
        const float* src = tmp + ((size_t)(b * 2 + 1) * 2 * SEQ + (size_t)g * SEQ + pos) * 128;
        bf16_t* dst = (bf16_t*)(ws + (b ? O_VW : O_VS)) + ((size_t)g * 128 + (pos >> 6)) * 8192;
#pragma unroll
        for (int hh = 0; hh < 2; ++hh) { const int d = lane + 64 * hh;
            u32x2 w; w.x = cvt_pk_bf16(src[d], src[128 + d]); w.y = cvt_pk_bf16(src[256 + d], src[384 + d]);
            *(u32x2*)(dst + vswz(pos & 63, d)) = w; }
    }
}
__device__ __forceinline__ void phase_cmpprep(const Params& P) {
    unsigned char* ws = P.ws;
    const int tid = otid(), lane = tid & 63, gwave = blockIdx.x * 8 + (tid >> 6), nwaves = gridDim.x * 8;
    const float* craw = (const float*)(ws + O_CRAW);
    for (int it = gwave; it < 1024; it += nwaves) {
        const f32x2 v = *(const f32x2*)(craw + (size_t)it * 128 + 2 * lane);
        const float rs = __builtin_amdgcn_rsqf(wave_sum(v[0] * v[0] + v[1] * v[1]) * (1.0f / 128.0f) + EPSF);
        *(unsigned*)((bf16_t*)(ws + O_KCMP) + (size_t)it * 128 + 2 * lane) = cvt_pk_bf16(v[0] * rs * P.k_norm[2 * lane], v[1] * rs * P.k_norm[2 * lane + 1]);
    }
    for (int it = gwave; it < 1024 / 4; it += nwaves) {
        const int r0 = it * 4, g = r0 >> 9, i0 = r0 & 511;
        const float* src = craw + (size_t)(1024 + r0) * 128;
        bf16_t* dst = (bf16_t*)(ws + O_VCMP) + ((size_t)g * 8 + (i0 >> 6)) * 8192;
#pragma unroll
        for (int hh = 0; hh < 2; ++hh) { const int d = lane + 64 * hh;
            u32x2 w; w.x = cvt_pk_bf16(src[d], src[128 + d]); w.y = cvt_pk_bf16(src[256 + d], src[384 + d]);
            *(u32x2*)(dst + vswz(i0 & 63, d)) = w; }
    }
}

constexpr int AT_PK = 8192, AT_SC = AT_PK + 32768, AT_MSK = AT_SC + 4096, AT_KV = 49152;
template <int MODE, bool FAR>
__device__ __forceinline__ void attn_block(const LAS unsigned char* Ks, const LAS unsigned char* Vs, const bf16x8 (&qf)[4], int dist0, int dstep, int wlimit, bool colok,
                                           const LAS float* biasl, float& m, float& l, f32x4 (&O)[8], float mfin, float linv, LAS float* pk, int lane) {
    const int fr = lane & 15, fq = lane >> 4;
    f32x4 s[4];
#pragma unroll
    for (int kt = 0; kt < 4; ++kt) s[kt] = (f32x4){0.f, 0.f, 0.f, 0.f};
    {
        bf16x8 kfa[4], kfb[4];
#define AT_LDK(dst, KK) _Pragma("unroll") for (int kt = 0; kt < 4; ++kt) dst[kt] = *(const LAS bf16x8*)(Ks + (16 * kt + fr) * 256 + (((4 * (KK) + fq) ^ fr) << 4))
#define AT_MMK(src, KK) _Pragma("unroll") for (int kt = 0; kt < 4; ++kt) s[kt] = __builtin_amdgcn_mfma_f32_16x16x32_bf16(src[kt], qf[KK], s[kt], 0, 0, 0)
        AT_LDK(kfa, 0); AT_LDK(kfb, 1);
        __builtin_amdgcn_sched_barrier(0);
        AT_MMK(kfa, 0); AT_LDK(kfa, 2);
        __builtin_amdgcn_sched_barrier(0);
        AT_MMK(kfb, 1); AT_LDK(kfb, 3);
        __builtin_amdgcn_sched_barrier(0);
        AT_MMK(kfa, 2);
        __builtin_amdgcn_sched_barrier(0);
        AT_MMK(kfb, 3);
        __builtin_amdgcn_sched_barrier(0);
#undef AT_LDK
#undef AT_MMK
    }
    bf16x8 vfa[4], vfb[4];
#define AT_LDV(dst, KS, DH) _Pragma("unroll") for (int d4 = 0; d4 < 4; ++d4) dst[d4] = *(const LAS bf16x8*)(Vs + (((4 * (DH) + d4) * 2 + (KS)) * 64 + lane) * 16)
#define AT_MMV(src, PB, DH) _Pragma("unroll") for (int d4 = 0; d4 < 4; ++d4) O[4 * (DH) + d4] = __builtin_amdgcn_mfma_f32_16x16x32_bf16(src[d4], PB, O[4 * (DH) + d4], 0, 0, 0)
    if (MODE != 0) { AT_LDV(vfa, 0, 0); }
    __builtin_amdgcn_sched_barrier(0);
    float ps = 0.f;
    if (FAR) {
        const float c = colok ? biasl[127 * 16] : -300.0f;
#pragma unroll
        for (int kt = 0; kt < 4; ++kt)
#pragma unroll
            for (int j = 0; j < 4; ++j) { float pv = __builtin_amdgcn_exp2f(s[kt][j] + c); if (MODE == 1) pv *= linv; s[kt][j] = pv; ps += pv; }
    } else {
        float bv[4][4];
#pragma unroll
        for (int kt = 0; kt < 4; ++kt)
#pragma unroll
            for (int j = 0; j < 4; ++j) { const int dist = dist0 - dstep * (16 * kt + 4 * fq + j); const int di = dist < 0 ? 0 : (dist > 127 ? 127 : dist); bv[kt][j] = biasl[di * 16]; }
        __builtin_amdgcn_sched_barrier(0);
#pragma unroll
        for (int kt = 0; kt < 4; ++kt)
#pragma unroll
            for (int j = 0; j < 4; ++j) { const int dist = dist0 - dstep * (16 * kt + 4 * fq + j);
                const bool ok = colok && dist >= 0 && dist < wlimit;
                float pv = __builtin_amdgcn_exp2f(ok ? s[kt][j] + bv[kt][j] : -300.0f); if (MODE == 1) pv *= linv; s[kt][j] = pv; ps += pv; }
    }
    if (MODE != 1) l += ps;
    if (MODE == 0) return;
    if (MODE == 1) {
#pragma unroll
        for (int kt = 0; kt < 4; ++kt)
#pragma unroll
            for (int j = 0; j < 4; ++j) { float v = s[kt][j]; v += __shfl_xor(v, 1); v += __shfl_xor(v, 2); v += __shfl_xor(v, 4);
                if ((fr & 7) == 0) pk[(fr >> 3) * 512 + 16 * kt + 4 * fq + j] = v; }
    }
    bf16x8 pb[2];
#pragma unroll
    for (int ks = 0; ks < 2; ++ks) {
        u32x4 pw; pw.x = cvt_pk_bf16(s[2 * ks][0], s[2 * ks][1]); pw.y = cvt_pk_bf16(s[2 * ks][2], s[2 * ks][3]);
        pw.z = cvt_pk_bf16(s[2 * ks + 1][0], s[2 * ks + 1][1]); pw.w = cvt_pk_bf16(s[2 * ks + 1][2], s[2 * ks + 1][3]);
        pb[ks] = __builtin_bit_cast(bf16x8, pw);
    }
    AT_LDV(vfb, 0, 1);
    __builtin_amdgcn_sched_barrier(0);
    AT_MMV(vfa, pb[0], 0); AT_LDV(vfa, 1, 0);
    __builtin_amdgcn_sched_barrier(0);
    AT_MMV(vfb, pb[0], 1); AT_LDV(vfb, 1, 1);
    __builtin_amdgcn_sched_barrier(0);
    AT_MMV(vfa, pb[1], 0);
    __builtin_amdgcn_sched_barrier(0);
    AT_MMV(vfb, pb[1], 1);
    __builtin_amdgcn_sched_barrier(0);
#undef AT_LDV
#undef AT_MMV
}

__device__ __forceinline__ int t5_bucket_dev(int n) {
    if (n < 16) return n;
    int b = 16;
    b += (n >= 19) + (n >= 21) + (n >= 24) + (n >= 27) + (n >= 31) + (n >= 35) + (n >= 40) + (n >= 46) + (n >= 52) + (n >= 59) + (n >= 67) + (n >= 77) + (n >= 87) + (n >= 99) + (n >= 113);
    return b;
}
__device__ __forceinline__ unsigned long long bit_range64(int a, int b) {
    if (a < 0) a = 0; if (b > 63) b = 63; if (b < a) return 0ull;
    const int n = b - a + 1; return (n >= 64 ? ~0ull : ((1ull << n) - 1ull)) << a;
}
__device__ __forceinline__ bool bit128(unsigned long long lo, unsigned long long hi, int j) { return (((j < 64 ? lo >> j : hi >> (j - 64))) & 1ull) != 0ull; }

__device__ __forceinline__ int first_bit128(unsigned long long lo, unsigned long long hi) { return lo ? __builtin_ctzll(lo) : (hi ? 64 + __builtin_ctzll(hi) : -1); }
template <int MODE, int KIND>
__device__ __forceinline__ void attn_stream(LAS unsigned char* lds, int& rb, unsigned long long mlo, unsigned long long mhi, const bf16_t* Kbase, const bf16_t* Vbase,
                                            const bf16x8 (&qf)[4], int tq, int t0, unsigned long long sel_lo, unsigned long long sel_hi, unsigned long long wsel_lo, unsigned long long wsel_hi,
                                            const LAS float* biasl, float& m, float& l, f32x4 (&O)[8], float mfin, float linv, LAS float* pk, int tid, int lane) {
    const int wave = __builtin_amdgcn_readfirstlane(tid >> 6);
    unsigned ksrc[2];
#pragma unroll
    for (int i = 0; i < 2; ++i) { const int sl = tid + 512 * i, r = sl >> 4, c = sl & 15; ksrc[i] = (unsigned)(r * 128 + ((c ^ (r & 15)) << 3)); }
#define AT_ISSUE(JB, RB) do { const bf16_t* kb_ = Kbase + (size_t)(JB) * 8192; LAS unsigned char* dst_ = lds + AT_KV + (RB) * 32768 + wave * 1024; \
        _Pragma("unroll") for (int i_ = 0; i_ < 2; ++i_) __builtin_amdgcn_global_load_lds((const unsigned*)(kb_ + ksrc[i_]), (LAS unsigned*)(dst_ + i_ * 8192), 16, 0, 0); \
        if (MODE != 0) { const bf16_t* vb_ = Vbase + (size_t)(JB) * 8192 + tid * 8; \
            _Pragma("unroll") for (int i_ = 0; i_ < 2; ++i_) __builtin_amdgcn_global_load_lds((const unsigned*)(vb_ + i_ * 4096), (LAS unsigned*)(dst_ + 16384 + i_ * 8192), 16, 0, 0); } } while (0)
    int j = first_bit128(mlo, mhi);
    if (j < 0) return;
    if (j < 64) mlo &= mlo - 1; else mhi &= mhi - 1;
    int jn = first_bit128(mlo, mhi);
    AT_ISSUE(j, rb);
    if (jn >= 0) { if (jn < 64) mlo &= mlo - 1; else mhi &= mhi - 1; AT_ISSUE(jn, (rb + 1) % 3); }
    while (j >= 0) {
        if (jn >= 0) { if (MODE == 0) asm volatile("s_waitcnt vmcnt(2)" ::: "memory"); else asm volatile("s_waitcnt vmcnt(4)" ::: "memory"); }
        else asm volatile("s_waitcnt vmcnt(0)" ::: "memory");
        asm volatile("s_waitcnt lgkmcnt(0)" ::: "memory");
        __builtin_amdgcn_s_barrier();
        asm volatile("" ::: "memory");
        const int jnn = first_bit128(mlo, mhi);
        if (jnn >= 0) { if (jnn < 64) mlo &= mlo - 1; else mhi &= mhi - 1; AT_ISSUE(jnn, (rb + 2) % 3); }
        if (KIND != 1 || bit128(wsel_lo, wsel_hi, j)) {
            const LAS unsigned char* Ks = lds + AT_KV + rb * 32768; const LAS unsigned char* Vs = Ks + 16384;
            const int dist0 = KIND == 0 ? tq - 31 - 1024 * j : tq - 64 * j;
            const bool colok = KIND == 1 ? bit128(sel_lo, sel_hi, j) : true;
            const bool far = KIND == 0 ? (t0 - 31 - 1024 * j - 1008 >= 127) : (KIND == 1 ? (t0 - 64 * j - 63 >= 127) : (t0 - 64 * j - 63 >= 127 && t0 + 15 - 64 * j <= 511));
            if (far) attn_block<MODE, true>(Ks, Vs, qf, dist0, KIND == 0 ? 16 : 1, KIND == 2 ? 512 : 0x7fffffff, colok, biasl, m, l, O, mfin, linv, pk + (KIND == 0 ? 64 * j : 0), lane);
            else attn_block<MODE, false>(Ks, Vs, qf, dist0, KIND == 0 ? 16 : 1, KIND == 2 ? 512 : 0x7fffffff, colok, biasl, m, l, O, mfin, linv, pk + (KIND == 0 ? 64 * j : 0), lane);
        }
        rb = (rb + 1) % 3; j = jn; jn = jnn;
    }
#undef AT_ISSUE
}

__device__ __forceinline__ void phase_attn(const Params& P, LAS unsigned char* lds, int jl  ) {
    unsigned char* ws = P.ws;
    const int tid = otid(), lane = tid & 63, wave = __builtin_amdgcn_readfirstlane(tid >> 6), fr = lane & 15, fq = lane >> 4;
    LAS float* biasT = (LAS float*)lds;
    LAS float* pk = (LAS float*)(lds + AT_PK) + wave * 1024;
    LAS float* sc = (LAS float*)(lds + AT_SC) + wave * 128;
    LAS unsigned long long* msk = (LAS unsigned long long*)(lds + AT_MSK);
    __syncthreads();
    for (int i = tid; i < 2048; i += NTHREADS) biasT[i] = P.rel_bias[t5_bucket_dev(i >> 4) * 16 + (i & 15)] * 1.4426950408889634f;
    LDS_WAIT(); __syncthreads();
    const bf16_t* Q = (const bf16_t*)(ws + O_ZU); const float* gates = (const float*)(ws + O_GATES); bf16_t* Y = (bf16_t*)(ws + O_Y);
    const float* qn = P.b_q_norm + jl * 128;
    const int h = fr & 7;
    int buf = 0;
    for (int wg = blockIdx.x; wg < 256; wg += gridDim.x) {
        for (int it = 0; it < 4; ++it) {
            const int ti = (it & 2) ? 511 - wg : wg, g = it & 1, t0 = 16 * ti;
            const int tq = t0 + 2 * wave + (fr >> 3), head = g * 8 + h;
            const LAS float* biasl = biasT + head;
            const bf16_t* KS = (const bf16_t*)(ws + O_KS) + (size_t)g * SEQ * 128; const bf16_t* VS = (const bf16_t*)(ws + O_VS) + (size_t)g * SEQ * 128;
            const bf16_t* KW = (const bf16_t*)(ws + O_KW) + (size_t)g * SEQ * 128; const bf16_t* VW = (const bf16_t*)(ws + O_VW) + (size_t)g * SEQ * 128;
            const bf16_t* KC = (const bf16_t*)(ws + O_KCMP) + (size_t)g * 512 * 128; const bf16_t* VC = (const bf16_t*)(ws + O_VCMP) + (size_t)g * 512 * 128;
            bf16x8 qf[4];
            {
                const bf16_t* qp = Q + (size_t)tq * 2048 + head * 128 + 8 * fq; float qv[4][8]; float sq = 0.f;
#pragma unroll
                for (int kk = 0; kk < 4; ++kk) { const u32x4 w = *(const u32x4*)(qp + 32 * kk); const unsigned ww[4] = {w.x, w.y, w.z, w.w};
#pragma unroll
                    for (int e = 0; e < 4; ++e) { qv[kk][2 * e] = bflo(ww[e]); qv[kk][2 * e + 1] = bfhi(ww[e]); sq += qv[kk][2 * e] * qv[kk][2 * e] + qv[kk][2 * e + 1] * qv[kk][2 * e + 1]; } }
                sq += __shfl_xor(sq, 16); sq += __shfl_xor(sq, 32);
                const float rs = __builtin_amdgcn_rsqf(sq * (1.0f / 128.0f) + EPSF) * (0.08838834764831845f * 1.4426950408889634f);
#pragma unroll
                for (int kk = 0; kk < 4; ++kk) { const f32x4 n0 = *(const f32x4*)(qn + 32 * kk + 8 * fq), n1 = *(const f32x4*)(qn + 32 * kk + 8 * fq + 4); u32x4 w;
                    w.x = cvt_pk_bf16(qv[kk][0] * rs * n0[0], qv[kk][1] * rs * n0[1]); w.y = cvt_pk_bf16(qv[kk][2] * rs * n0[2], qv[kk][3] * rs * n0[3]);
                    w.z = cvt_pk_bf16(qv[kk][4] * rs * n1[0], qv[kk][5] * rs * n1[1]); w.w = cvt_pk_bf16(qv[kk][6] * rs * n1[2], qv[kk][7] * rs * n1[3]);
                    qf[kk] = __builtin_bit_cast(bf16x8, w); }
            }
            const float g_c = gates[(size_t)tq * 48 + head * 3 + 0], g_s = gates[(size_t)tq * 48 + head * 3 + 1], g_w = gates[(size_t)tq * 48 + head * 3 + 2];
            u32x2 OT[8]; f32x4 O[8];
#pragma unroll
            for (int dt = 0; dt < 8; ++dt) { OT[dt] = (u32x2){0u, 0u}; O[dt] = (f32x4){0.f, 0.f, 0.f, 0.f}; }
#pragma unroll
            for (int e = 0; e < 16; ++e) pk[lane + 64 * e] = 0.f;
            LDS_WAIT();
            {
                const int tmax = t0 + 15, kmaxT = tmax >= 31 ? (tmax - 31) >> 4 : -1, nb = kmaxT >= 0 ? (kmaxT >> 6) + 1 : 0;
                const unsigned long long cm = nb ? ((1ull << nb) - 1ull) : 0ull;
                float m = -1e30f, l = 0.f;
                attn_stream<0, 0>(lds, buf, cm, 0ull, KC, VC, qf, tq, t0, 0ull, 0ull, 0ull, 0ull, biasl, m, l, O, 0.f, 0.f, pk, tid, lane);
                l += __shfl_xor(l, 16); l += __shfl_xor(l, 32);
                const float linv = l > 0.f ? 1.0f / l : 0.f;
                attn_stream<1, 0>(lds, buf, cm, 0ull, KC, VC, qf, tq, t0, 0ull, 0ull, 0ull, 0ull, biasl, m, l, O, m, linv, pk, tid, lane);
#pragma unroll
                for (int dt = 0; dt < 8; ++dt) { OT[dt].x = cvt_pk_bf16(O[dt][0] * g_c, O[dt][1] * g_c); OT[dt].y = cvt_pk_bf16(O[dt][2] * g_c, O[dt][3] * g_c); }
            }
            LDS_WAIT();
            unsigned long long ma0 = 0, ma1 = 0, mb0 = 0, mb1 = 0;
#pragma unroll
            for (int q = 0; q < 2; ++q) {
                const int tqq = t0 + 2 * wave + q, cur = tqq >> 6; const LAS float* pq = pk + q * 512;
                unsigned key[2];
#pragma unroll
                for (int e = 0; e < 2; ++e) { const int jb = lane + 64 * e;
                    const float imp = pq[4 * jb] + pq[4 * jb + 1] + pq[4 * jb + 2] + 0.5f * pq[4 * jb + 3] + (jb > 0 ? 0.5f * pq[4 * jb - 1] : 0.f);
                    const bool forced = (jb == 0) || (jb == cur) || (jb == cur - 1);
                    key[e] = jb <= cur ? __float_as_uint(forced ? 3.0e38f : imp) + 1u : 0u; }
                const int need = cur + 1 < 16 ? cur + 1 : 16;
                unsigned T = 0u;
                for (int bit = 30; bit >= 0; --bit) { const unsigned cand = T | (1u << bit);
                    const int c = __popcll(__ballot(key[0] >= cand)) + __popcll(__ballot(key[1] >= cand));
                    if (c >= need) T = cand; }
                const unsigned long long e0 = __ballot(key[0] == T), e1 = __ballot(key[1] == T), lm = (1ull << lane) - 1ull;
                const int rem = need - __popcll(__ballot(key[0] > T)) - __popcll(__ballot(key[1] > T));
                const unsigned long long k0 = __ballot(key[0] > T || (key[0] == T && __popcll(e0 & lm) < rem));
                const unsigned long long k1 = __ballot(key[1] > T || (key[1] == T && __popcll(e0) + __popcll(e1 & lm) < rem));
                if (q == 0) { ma0 = k0; ma1 = k1; } else { mb0 = k0; mb1 = k1; }
                LDS_WAIT();
            }
            __syncthreads();
            if (lane == 0) { msk[(2 * wave) * 2] = ma0; msk[(2 * wave) * 2 + 1] = ma1; msk[(2 * wave + 1) * 2] = mb0; msk[(2 * wave + 1) * 2 + 1] = mb1; }
            LDS_WAIT(); __syncthreads();
            unsigned long long ulo = 0, uhi = 0;
#pragma unroll
            for (int q = 0; q < 16; ++q) { ulo |= msk[2 * q]; uhi |= msk[2 * q + 1]; }
            ulo = ((unsigned long long)__builtin_amdgcn_readfirstlane((unsigned)(ulo >> 32)) << 32) | (unsigned)__builtin_amdgcn_readfirstlane((unsigned)ulo);
            uhi = ((unsigned long long)__builtin_amdgcn_readfirstlane((unsigned)(uhi >> 32)) << 32) | (unsigned)__builtin_amdgcn_readfirstlane((unsigned)uhi);
            {
                float m = -1e30f, l = 0.f;
#pragma unroll
                for (int dt = 0; dt < 8; ++dt) O[dt] = (f32x4){0.f, 0.f, 0.f, 0.f};
                const unsigned long long sl = fr < 8 ? ma0 : mb0, sh = fr < 8 ? ma1 : mb1;
                attn_stream<2, 1>(lds, buf, ulo, uhi, KS, VS, qf, tq, t0, sl, sh, ma0 | mb0, ma1 | mb1, biasl, m, l, O, 0.f, 0.f, pk, tid, lane);
                l += __shfl_xor(l, 16); l += __shfl_xor(l, 32);
                const float sc_ = g_s / l;
#pragma unroll
                for (int dt = 0; dt < 8; ++dt) { OT[dt].x = cvt_pk_bf16(bflo(OT[dt].x) + O[dt][0] * sc_, bfhi(OT[dt].x) + O[dt][1] * sc_); OT[dt].y = cvt_pk_bf16(bflo(OT[dt].y) + O[dt][2] * sc_, bfhi(OT[dt].y) + O[dt][3] * sc_); }
            }
            {
                float m = -1e30f, l = 0.f;
#pragma unroll
                for (int dt = 0; dt < 8; ++dt) O[dt] = (f32x4){0.f, 0.f, 0.f, 0.f};
                const int jb0 = t0 >= 511 ? (t0 - 511) >> 6 : 0, jb1 = (t0 + 15) >> 6;
                attn_stream<2, 2>(lds, buf, bit_range64(jb0, jb1), bit_range64(jb0 - 64, jb1 - 64), KW, VW, qf, tq, t0, 0ull, 0ull, 0ull, 0ull, biasl, m, l, O, 0.f, 0.f, pk, tid, lane);
                l += __shfl_xor(l, 16); l += __shfl_xor(l, 32);
                const float sc_ = g_w / l;
#pragma unroll
                for (int dt = 0; dt < 8; ++dt) { OT[dt].x = cvt_pk_bf16(bflo(OT[dt].x) + O[dt][0] * sc_, bfhi(OT[dt].x) + O[dt][1] * sc_); OT[dt].y = cvt_pk_bf16(bflo(OT[dt].y) + O[dt][2] * sc_, bfhi(OT[dt].y) + O[dt][3] * sc_); }
            }
            {
                bf16_t* yp = Y + (size_t)tq * 2048 + head * 128 + 4 * fq;
#pragma unroll
                for (int dt = 0; dt < 8; ++dt) *(u32x2*)(yp + 16 * dt) = OT[dt];
            }
        }
    }
    __syncthreads();
}

#define XB_TMO      128
#define XB_XCNT(j)  (256  + 64 * (j))
#define XB_XSUB(j)  (1280 + 64 * (j))
#define XB_XGEN(j)  (2304 + 64 * (j))
#define XB_TOP      3328
#define XB_TOPGEN   3392
#define XB_SPIN_CAP (1u << 18)
__device__ __forceinline__ unsigned xb_ld(unsigned* p)              { return __hip_atomic_load(p, __ATOMIC_RELAXED, __HIP_MEMORY_SCOPE_AGENT); }
__device__ __forceinline__ unsigned xb_add(unsigned* p, unsigned v) { return __hip_atomic_fetch_add(p, v, __ATOMIC_RELAXED, __HIP_MEMORY_SCOPE_AGENT); }
__device__ __forceinline__ unsigned xb_xcc_id() { return (unsigned)__builtin_amdgcn_s_getreg((3 << 11) | 20) & 0xFu; }
#define XB_SPIN(cond, bar) do { unsigned _sp = 0; while (cond) { __builtin_amdgcn_s_sleep(1); \
    if ((++_sp & 255u) == 0u) { if (xb_ld(&(bar)[XB_TMO])) break; if (_sp > XB_SPIN_CAP) { atomicAdd(&(bar)[XB_TMO], 1u); break; } } } } while (0)
struct XcdBarrier { unsigned* bar; unsigned x; volatile LAS unsigned* st; };
__device__ __forceinline__ XcdBarrier xcd_barrier_post(unsigned* bar, volatile LAS unsigned* st) {
    XcdBarrier b; b.bar = bar; b.x = xb_xcc_id(); b.st = st;
    if (threadIdx.x == 0) (void)xb_add(&bar[XB_XCNT(b.x)], 1u);
    return b;
}
__device__ __forceinline__ void xcd_barrier_complete(unsigned* bar, unsigned x, unsigned& nloc, unsigned& nx) {
    const unsigned G = gridDim.x * gridDim.y * gridDim.z;
    unsigned sum, cnt, mine, sp = 0u;
    for (;;) {
        sum = 0u; cnt = 0u; mine = 0u;
#pragma unroll
        for (unsigned j = 0; j < 16; ++j) { const unsigned c = xb_ld(&bar[XB_XCNT(j)]); sum += c; cnt += (c > 0u) ? 1u : 0u; mine = (j == x) ? c : mine; }
        if (sum == G) break;
        __builtin_amdgcn_s_sleep(1);
        if ((++sp & 255u) == 0u) { if (xb_ld(&bar[XB_TMO])) break; if (sp > XB_SPIN_CAP) { atomicAdd(&bar[XB_TMO], 1u); break; } }
    }
    nloc = mine > 0u ? mine : 1u; nx = cnt > 0u ? cnt : 1u;
}
__device__ __forceinline__ void xcd_barrier(const XcdBarrier& b) {
    asm volatile("s_waitcnt vmcnt(0)" ::: "memory");
    __syncthreads();
    if (threadIdx.x == 0) {
        unsigned* bar = b.bar;
        __builtin_amdgcn_s_waitcnt(0);
        unsigned nloc = b.st[0], nx = b.st[1];
        if (nloc == 0u) { xcd_barrier_complete(bar, b.x, nloc, nx); b.st[0] = nloc; b.st[1] = nx; }
        const unsigned old = xb_add(&bar[XB_XSUB(b.x)], 1u);
        const unsigned gen = old / nloc;
        if (old + 1u == (gen + 1u) * nloc) {
            __builtin_amdgcn_fence(__ATOMIC_RELEASE, "agent");
            asm volatile("s_waitcnt vmcnt(0)" ::: "memory");
            const unsigned og = xb_add(&bar[XB_TOP], 1u);
            const unsigned tg = og / nx;
            if (og + 1u == (tg + 1u) * nx) xb_add(&bar[XB_TOPGEN], 1u);
            else XB_SPIN(xb_ld(&bar[XB_TOPGEN]) == tg, bar);
            __builtin_amdgcn_fence(__ATOMIC_ACQUIRE, "agent");
            xb_add(&bar[XB_XGEN(b.x)], 1u);
            asm volatile("s_waitcnt vmcnt(0)" ::: "memory");
        } else {
            XB_SPIN(xb_ld(&bar[XB_XGEN(b.x)]) == gen, bar);
            __builtin_amdgcn_fence(__ATOMIC_ACQUIRE, "agent");
            asm volatile("s_waitcnt vmcnt(0)" ::: "memory");
        }
    }
    __syncthreads();
}

__global__ void __launch_bounds__(NTHREADS, 2) yoco_fwd(Params P) {
    extern __shared__ __attribute__((aligned(16))) unsigned char lds_raw[];
    LAS unsigned char* lds = (LAS unsigned char*)lds_raw;
    cg::grid_group grid = cg::this_grid();
    unsigned char* ws = P.ws;
    const int G = gridDim.x, bid = blockIdx.x;
    float* SS = (float*)(ws + O_SS);
    bf16_t* XB0 = (bf16_t*)(ws + O_XB); bf16_t* XB1 = XB0 + (size_t)SEQ * DM;
    pg8::StaticOrder S;

    volatile LAS unsigned* bst = (volatile LAS unsigned*)(lds + 147456);
    if (threadIdx.x < 4) bst[threadIdx.x] = 0u;
    __syncthreads();
    const XcdBarrier xbar = xcd_barrier_post((unsigned*)(ws + O_BAR), bst);
    phase_prologue(P, lds);
    grid.sync();

    for (int layer = 0; layer < 4; ++layer) {
        bf16_t* xcur = (layer & 1) ? XB1 : XB0; bf16_t* xoth = (layer & 1) ? XB0 : XB1;
        const float* ss_mix = SS + (size_t)(3 * layer) * SEQ * 32; float* ss_ffn = SS + (size_t)(3 * layer + 1) * SEQ * 32; float* ss_ple = SS + (size_t)(3 * layer + 2) * SEQ * 32;
        float* ss_next = layer < 3 ? SS + (size_t)(3 * layer + 3) * SEQ * 32 : nullptr;
        const float* xres0 = layer == 0 ? P.x : P.out;
        if (layer < 2) {
            {
                pg8::Gemm g{xcur, (const bf16_t*)(ws + O_WAIN) + (size_t)layer * 4096 * 2048, SEQ, 4096, 2048, 2048}; S.init(SEQ, 4096, G, bid);
                Epi<EP_GMLP_IN> E; E.p = EpiP{ss_mix, nullptr, nullptr, nullptr, nullptr, (bf16_t*)(ws + O_ZU), (bf16_t*)(ws + O_ZV), nullptr, nullptr, nullptr, (float*)(ws + O_SSV) + (size_t)layer * SEQ * 32};
                pg8::gemm_phase(lds, g, S, E);
            }
            xcd_barrier(xbar);
            phase_sgu(P, lds, layer);
            xcd_barrier(xbar);
            {
                pg8::Gemm g{(const bf16_t*)(ws + O_Y), (const bf16_t*)(ws + O_WAOUT) + (size_t)layer * 2048 * 2048, SEQ, 2048, 2048, 2048}; S.init(SEQ, 2048, G, bid);
                Epi<EP_RESID> E; E.p = EpiP{nullptr, ss_ffn, nullptr, nullptr, xoth, nullptr, xcur, nullptr, nullptr, nullptr, nullptr};
                pg8::gemm_phase(lds, g, S, E);
            }
            xcd_barrier(xbar);
        } else {
            const int j = layer - 2;
            if (j > 0) {
                pg8::Gemm g{xcur, (const bf16_t*)(ws + O_WBIN) + (size_t)j * NQP * 2048, SEQ, NQP, 2048, 2048}; S.init(SEQ, NQP, G, bid);
                Epi<EP_QG> E; E.p = EpiP{ss_mix, nullptr, nullptr, nullptr, nullptr, (bf16_t*)(ws + O_ZU), nullptr, (float*)(ws + O_GATES), nullptr, nullptr, nullptr};
                pg8::gemm_phase(lds, g, S, E);
                if (G == 256 && bid >= 32) {
                    const int tidc = otid();
                    convert_set(P, lds, 5, (bid - 32) * 8 + (tidc >> 6), 224 * 8, tidc & 63, tidc >> 6);
                }
                xcd_barrier(xbar);
            }
            phase_attn(P, lds, j);
            xcd_barrier(xbar);
            {
                pg8::Gemm g{(const bf16_t*)(ws + O_Y), (const bf16_t*)(ws + O_WBOUT) + (size_t)j * 2048 * 2048, SEQ, 2048, 2048, 2048}; S.init(SEQ, 2048, G, bid);
                Epi<EP_RESID> E; E.p = EpiP{nullptr, ss_ffn, nullptr, nullptr, xoth, nullptr, xcur, nullptr, nullptr, nullptr, nullptr};
                pg8::gemm_phase(lds, g, S, E);
            }
            xcd_barrier(xbar);
        }
        {
            pg8::Gemm g{xoth, (const bf16_t*)(ws + O_WFIN) + (size_t)layer * 11264 * 2048, SEQ, 11264, 2048, 2048}; S.init(SEQ, 11264, G, bid);
            Epi<EP_FFN_IN> E; E.p = EpiP{ss_ffn, nullptr, nullptr, nullptr, nullptr, (bf16_t*)(ws + O_HID), nullptr, nullptr, nullptr, nullptr, nullptr};
            pg8::gemm_phase(lds, g, S, E);
            if (G == 256 && bid >= 128) {
                const int tidc = otid();
                convert_set(P, lds, 1 + layer, (bid - 128) * 8 + (tidc >> 6), 128 * 8, tidc & 63, tidc >> 6);
                __syncthreads();
            }
            pg8::Gemm g2{(const bf16_t*)(ws + O_PB) + (size_t)layer * SEQ * PLED, (const bf16_t*)(ws + O_WPW) + (size_t)layer * 2048 * 256, SEQ, 2048, 256, 256}; S.init(SEQ, 2048, G, bid);
            Epi<EP_PROJ> E2; E2.p = EpiP{nullptr, nullptr, nullptr, nullptr, nullptr, (bf16_t*)(ws + O_PROJ), nullptr, nullptr, nullptr, nullptr, nullptr};
            pg8::gemm_phase(lds, g2, S, E2);
        }
        xcd_barrier(xbar);
        {
            pg8::Gemm g{(const bf16_t*)(ws + O_HID), (const bf16_t*)(ws + O_WFOUT) + (size_t)layer * 2048 * FFD, SEQ, 2048, FFD, FFD}; S.init(SEQ, 2048, G, bid);
            Epi<EP_RESID> E; E.p = EpiP{nullptr, ss_ple, nullptr, nullptr, xcur, nullptr, xoth, nullptr, nullptr, nullptr, nullptr};
            pg8::gemm_phase(lds, g, S, E);
        }
        xcd_barrier(xbar);
        {
            pg8::Gemm g{xcur, (const bf16_t*)(ws + O_WPG) + (size_t)layer * 2048 * 2048, SEQ, 2048, 2048, 2048}; S.init(SEQ, 2048, G, bid);
            Epi<EP_PLE> E; E.p = EpiP{ss_ple, ss_next, nullptr, layer == 3 ? P.out : nullptr, layer == 3 ? nullptr : xoth, nullptr, xcur, nullptr, (const bf16_t*)(ws + O_PROJ), nullptr, nullptr};
            pg8::gemm_phase(lds, g, S, E);
        }
        xcd_barrier(xbar);
        if (layer == 1) {
            {
                pg8::Gemm g{xoth, (const bf16_t*)(ws + O_WKV), SEQ, NKVC, 2048, 2048}; S.init(SEQ, NKVC, G, bid);
                Epi<EP_KV> E; E.p = EpiP{ss_next, nullptr, nullptr, nullptr, nullptr, (bf16_t*)(ws + O_KC), (bf16_t*)(ws + O_VC), (float*)(ws + O_KVTMP), nullptr, nullptr, nullptr};
                pg8::gemm_phase(lds, g, S, E);
            }
            xcd_barrier(xbar);
            phase_kvprep(P);
            if (bid < 8) {
                pg8::Gemm g{(const bf16_t*)(ws + O_KC), (const bf16_t*)(ws + O_WC1), 1024, 256, 4096, 2048}; S.init(1024, 256, G, bid);
                Epi<EP_C1> E; E.p = EpiP{nullptr, nullptr, nullptr, nullptr, nullptr, (bf16_t*)(ws + O_HK), nullptr, nullptr, nullptr, (const float*)(ws + O_CB), nullptr};
                pg8::gemm_phase(lds, g, S, E);
                pg8::Gemm g2{(const bf16_t*)(ws + O_VC), (const bf16_t*)(ws + O_WC1) + 256ull * 4096, 1024, 256, 4096, 2048}; S.init(1024, 256, G, (bid + G - 4) % G);
                Epi<EP_C1> E2; E2.p = EpiP{nullptr, nullptr, nullptr, nullptr, nullptr, (bf16_t*)(ws + O_HV), nullptr, nullptr, nullptr, (const float*)(ws + O_CB) + 256, nullptr};
                pg8::gemm_phase(lds, g2, S, E2);
            } else {
                pg8::Gemm g{xoth, (const bf16_t*)(ws + O_WBIN), SEQ, NQP, 2048, 2048}; S.init(SEQ, NQP, G - 8, bid - 8);
                Epi<EP_QG> E; E.p = EpiP{ss_next, nullptr, nullptr, nullptr, nullptr, (bf16_t*)(ws + O_ZU), nullptr, (float*)(ws + O_GATES), nullptr, nullptr, nullptr};
                pg8::gemm_phase(lds, g, S, E);
            }
            xcd_barrier(xbar);
            {
                pg8::Gemm g{(const bf16_t*)(ws + O_HK), (const bf16_t*)(ws + O_WC2), 1024, 256, 256, 256}; S.init(1024, 256, G, bid);
                Epi<EP_C2> E; E.p = EpiP{nullptr, nullptr, nullptr, nullptr, nullptr, nullptr, nullptr, (float*)(ws + O_CRAW), nullptr, nullptr, nullptr};
                pg8::gemm_phase(lds, g, S, E);
                pg8::Gemm g2{(const bf16_t*)(ws + O_HV), (const bf16_t*)(ws + O_WC2) + 256ull * 256, 1024, 256, 256, 256}; S.init(1024, 256, G, (bid + G - 4) % G);
                Epi<EP_C2> E2; E2.p = EpiP{nullptr, nullptr, nullptr, nullptr, nullptr, nullptr, nullptr, (float*)(ws + O_CRAW) + 1024 * 128, nullptr, nullptr, nullptr};
                pg8::gemm_phase(lds, g2, S, E2);
            }
            xcd_barrier(xbar);
            phase_cmpprep(P);
            xcd_barrier(xbar);
        }
    }
}

extern "C" void kernel_launch(void* const* d_in, const int* in_sizes, int n_in, void* d_out, int out_size, void* d_ws, size_t ws_size, hipStream_t stream) {
    static int grid = 0;
    if (grid == 0) {
        if (n_in != 27 || ws_size < O_END) { fprintf(stderr, "kernel_launch: unexpected problem (n_in %d, ws %zu, need %zu)\n", n_in, ws_size, (size_t)O_END); grid = -1; return; }
        int dev = 0, cus = 0, per_cu = 0;
        hipGetDevice(&dev); hipDeviceGetAttribute(&cus, hipDeviceAttributeMultiprocessorCount, dev);
        if (hipFuncSetAttribute((const void*)yoco_fwd, hipFuncAttributeMaxDynamicSharedMemorySize, LDS_BYTES) != hipSuccess) { fprintf(stderr, "kernel_launch: hipFuncSetAttribute failed\n"); grid = -1; return; }
        if (hipOccupancyMaxActiveBlocksPerMultiprocessor(&per_cu, (const void*)yoco_fwd, NTHREADS, LDS_BYTES) != hipSuccess || per_cu < 1) { fprintf(stderr, "kernel_launch: occupancy query gave %d\n", per_cu); per_cu = 1; }
        (void)hipGetLastError();
        grid = cus * 1;
        if (grid > 256) grid = 256;
    }
    if (grid < 0) return;
    Params p{};
    const float** pp = (const float**)&p;
    for (int i = 0; i < 27; ++i) pp[i] = (const float*)d_in[i];
    p.out = (float*)d_out; p.ws = (unsigned char*)d_ws;
    if (hipMemsetAsync((unsigned char*)d_ws + O_BAR, 0, BAR_BYTES, stream) != hipSuccess) { fprintf(stderr, "kernel_launch: memset of the barrier words failed\n"); return; }
    void* args[] = {&p};
    hipError_t e = hipLaunchCooperativeKernel((const void*)yoco_fwd, dim3(grid), dim3(NTHREADS), args, LDS_BYTES, stream);
    if (e != hipSuccess) fprintf(stderr, "cooperative launch failed: %s (grid %d)\n", hipGetErrorString(e), grid);
}
```
